# Optimizing an MI355X kernel written in HIP

```python
import jax, jax.numpy as jnp
from jax import lax
import numpy as np

D_MODEL = 1024
BATCH = 16
SEQ = 2048
DEPTH = 1

CTX_LEN = 256
GRID_W = 64
POS_THETA = 10000.0
RMS_EPS = 1e-6
N_MOD = 6
RG_WIDTH = 512
RG_BLOCKS = 8
RG_C = 8.0
CONV_W = 4
GLA_HEADS = 4
GLA_DK = 64
GLA_DV = 128
GLA_WIDTH = GLA_HEADS * GLA_DV
GLA_RANK = 16
GLA_GATE_NORM = 16.0
GLA_CHUNK = 64
MIX_WIDTH = RG_WIDTH + GLA_WIDTH
IN_SPLITS = (RG_WIDTH, RG_WIDTH, GLA_HEADS * GLA_DK, GLA_HEADS * GLA_DK, GLA_WIDTH, GLA_WIDTH, 2 * GLA_RANK)
IN_COLS = 2 * RG_WIDTH + 2 * GLA_HEADS * GLA_DK + 2 * GLA_WIDTH + 2 * GLA_RANK
N_KEYS = 128
N_EXPERTS = N_KEYS * N_KEYS
PEER_HEADS = 8
PEER_DQ = 256
PEER_TOPK = 16
PEER_TOKEN_BLOCK = 128

kernel_name = "hymba_rglru_gla_peer_dit_block"


def _rmsnorm(x, g):
    xf = x.astype(jnp.float32)
    y = xf * lax.rsqrt(jnp.mean(xf * xf, axis=-1, keepdims=True) + RMS_EPS)
    return (y * g.astype(jnp.float32)).astype(x.dtype)


def _modulate(x, shift, scale):
    return x * (1 + scale) + shift


def _sincos_2d(n_tokens, dim, dtype):
    rows = n_tokens // GRID_W
    r, col = jnp.meshgrid(jnp.arange(rows, dtype=jnp.float32), jnp.arange(GRID_W, dtype=jnp.float32), indexing="ij")
    quarter = dim // 4
    omega = POS_THETA ** (-jnp.arange(quarter, dtype=jnp.float32) / quarter)

    def axis_embed(p):
        ang = p.reshape(-1)[:, None] * omega[None, :]
        return jnp.concatenate([jnp.sin(ang), jnp.cos(ang)], axis=-1)

    return jnp.concatenate([axis_embed(r), axis_embed(col)], axis=-1).astype(dtype)


def _split_cols(h):
    bounds = np.cumsum(np.array(IN_SPLITS))[:-1].tolist()
    return jnp.split(h, bounds, axis=-1)


def _centred_dwconv(x, w, b):
    t = x.shape[1]
    left = CONV_W // 2
    right = CONV_W - 1 - left
    xp = jnp.pad(x, ((0, 0), (left, right), (0, 0)))
    out = xp[:, 0:t] * w[0]
    for j in range(1, CONV_W):
        out = out + xp[:, j:j + t] * w[j]
    return out + b


def _affine_combine(left, right):
    a_l, b_l = left
    a_r, b_r = right
    return a_l * a_r, a_r * b_l + b_r


def _linear_scan(a, b, h0, reverse):
    if reverse:
        a = jnp.flip(a, axis=1)
        b = jnp.flip(b, axis=1)
    b = b.at[:, 0].add(a[:, 0] * h0)
    _, h = lax.associative_scan(_affine_combine, (a, b), axis=1)
    if reverse:
        h = jnp.flip(h, axis=1)
    return h


def _rglru_direction(xc, w_a, b_a, w_x, b_x, lam, h0, reverse):
    bsz, t, width = xc.shape
    xf = xc.astype(jnp.float32)
    xb = xf.reshape(bsz, t, RG_BLOCKS, width // RG_BLOCKS)
    gate_r = jax.nn.sigmoid(jnp.einsum("btgi,gij->btgj", xb, w_a.astype(jnp.float32)).reshape(bsz, t, width) + b_a.astype(jnp.float32))
    gate_i = jax.nn.sigmoid(jnp.einsum("btgi,gij->btgj", xb, w_x.astype(jnp.float32)).reshape(bsz, t, width) + b_x.astype(jnp.float32))
    log_a = -RG_C * gate_r * jax.nn.softplus(-lam.astype(jnp.float32))
    a = jnp.exp(log_a)
    b = jnp.sqrt(-jnp.expm1(2.0 * log_a)) * gate_i * xf
    return _linear_scan(a, b, h0, reverse)


def _rglru_mixer(x_ctx, x_lat, conv_w, conv_b, w_a, b_a, w_x, b_x, lam):
    xc_ctx = _centred_dwconv(x_ctx, conv_w, conv_b)
    xc_lat = _centred_dwconv(x_lat, conv_w, conv_b)
    bsz = x_lat.shape[0]
    h0 = jnp.zeros((bsz, RG_WIDTH), jnp.float32)
    h_ctx_f = _rglru_direction(xc_ctx, w_a[0], b_a[0], w_x[0], b_x[0], lam[0], h0, False)
    h_lat_f = _rglru_direction(xc_lat, w_a[0], b_a[0], w_x[0], b_x[0], lam[0], h_ctx_f[:, -1], False)
    h_ctx_b = _rglru_direction(xc_ctx, w_a[1], b_a[1], w_x[1], b_x[1], lam[1], h0, True)
    h_lat_b = _rglru_direction(xc_lat, w_a[1], b_a[1], w_x[1], b_x[1], lam[1], h_ctx_b[:, 0], True)
    return h_ctx_f + h_ctx_b, h_lat_f + h_lat_b


def _to_heads(t, dh):
    bsz, n, _ = t.shape
    return t.reshape(bsz, n, GLA_HEADS, dh).transpose(0, 2, 1, 3).astype(jnp.float32)


def _gla_chunked(q, k, v, log_alpha, s0, reverse, with_output):
    if reverse:
        q, k, v, log_alpha = (jnp.flip(z, axis=2) for z in (q, k, v, log_alpha))
    bsz, heads, t, _ = q.shape
    dv = v.shape[-1]
    n_chunks = t // GLA_CHUNK

    def chunk(z):
        return z.reshape(bsz, heads, n_chunks, GLA_CHUNK, z.shape[-1])

    q, k, v, log_alpha = chunk(q), chunk(k), chunk(v), chunk(log_alpha)
    b = jnp.cumsum(log_alpha, axis=3)
    b_last = b[:, :, :, -1:, :]
    ds = jnp.einsum("bhncd,bhncv->bhndv", k * jnp.exp(b_last - b), v)
    gamma = jnp.broadcast_to(jnp.exp(b_last[:, :, :, 0, :])[..., None], ds.shape)
    ds = ds.at[:, :, 0].add(gamma[:, :, 0] * s0)
    _, s_out = lax.associative_scan(_affine_combine, (gamma, ds), axis=2)
    s_end = s_out[:, :, -1]
    if not with_output:
        return None, s_end
    s_in = jnp.concatenate([s0[:, :, None], s_out[:, :, :-1]], axis=2)
    q_dec = q * jnp.exp(b)
    k_inv = k * jnp.exp(-b)
    lower = jnp.tril(jnp.ones((GLA_CHUNK, GLA_CHUNK), dtype=bool))
    scores = jnp.where(lower, jnp.einsum("bhnid,bhnjd->bhnij", q_dec, k_inv), 0.0)
    o = jnp.einsum("bhnij,bhnjv->bhniv", scores, v) + jnp.einsum("bhnid,bhndv->bhniv", q_dec, s_in)
    o = o.reshape(bsz, heads, t, dv)
    if reverse:
        o = jnp.flip(o, axis=2)
    return o, s_end


def _log_gate(lr, w_g, b_g, direction):
    z = lr[..., direction * GLA_RANK:(direction + 1) * GLA_RANK].astype(jnp.float32) @ w_g.astype(jnp.float32) + b_g.astype(jnp.float32)
    return _to_heads(jax.nn.log_sigmoid(z) / GLA_GATE_NORM, GLA_DK)


def _gla_mixer(q_c, k_c, v_c, lr_c, q_l, k_l, v_l, lr_l, w_g, b_g, with_ctx_out):
    scale = GLA_DK ** -0.5
    qc, kc, vc = _to_heads(q_c, GLA_DK) * scale, _to_heads(k_c, GLA_DK), _to_heads(v_c, GLA_DV)
    ql, kl, vl = _to_heads(q_l, GLA_DK) * scale, _to_heads(k_l, GLA_DK), _to_heads(v_l, GLA_DV)
    bsz = ql.shape[0]
    s0 = jnp.zeros((bsz, GLA_HEADS, GLA_DK, GLA_DV), jnp.float32)
    outs_c, outs_l = [], []
    for d, reverse in enumerate((False, True)):
        o_c, s_ctx = _gla_chunked(qc, kc, vc, _log_gate(lr_c, w_g[d], b_g[d], d), s0, reverse, with_ctx_out)
        o_l, _ = _gla_chunked(ql, kl, vl, _log_gate(lr_l, w_g[d], b_g[d], d), s_ctx, reverse, True)
        outs_c.append(o_c)
        outs_l.append(o_l)
    o_ctx = outs_c[0] + outs_c[1] if with_ctx_out else None
    return o_ctx, outs_l[0] + outs_l[1]


def _merge_groups(y_rg, gate_rg, o_gla, r_gla, norm_g, w_out):
    dtype = gate_rg.dtype
    bsz, t, _ = gate_rg.shape
    rg = y_rg.astype(dtype) * jax.nn.gelu(gate_rg, approximate=False)
    gla = _rmsnorm(o_gla, norm_g).transpose(0, 2, 1, 3).reshape(bsz, t, GLA_WIDTH).astype(dtype)
    gla = gla * jax.nn.silu(r_gla)
    return jnp.concatenate([rg, gla], axis=-1) @ w_out


def _peer(u, w_q, keys, u_tab, v_tab):
    bsz, t, dim = u.shape
    q = (u @ w_q).reshape(bsz, t, PEER_HEADS, 2, PEER_DQ // 2).astype(jnp.float32)
    s = jnp.einsum("bthpd,hpkd->bthpk", q, keys.astype(jnp.float32))
    s1, i1 = lax.top_k(s[..., 0, :], PEER_TOPK)
    s2, i2 = lax.top_k(s[..., 1, :], PEER_TOPK)
    n_cand = PEER_TOPK * PEER_TOPK
    cand_s = (s1[..., :, None] + s2[..., None, :]).reshape(bsz, t, PEER_HEADS, n_cand)
    cand_e = (i1[..., :, None] * N_KEYS + i2[..., None, :]).reshape(bsz, t, PEER_HEADS, n_cand)
    top_s, pos = lax.top_k(cand_s, PEER_TOPK)
    expert = jnp.take_along_axis(cand_e, pos, axis=-1)
    weight = jax.nn.softmax(top_s, axis=-1).astype(u.dtype)
    n_blocks = (bsz * t) // PEER_TOKEN_BLOCK
    n_sel = PEER_HEADS * PEER_TOPK
    u_blk = u.reshape(n_blocks, PEER_TOKEN_BLOCK, dim)
    e_blk = expert.reshape(n_blocks, PEER_TOKEN_BLOCK, n_sel)
    w_blk = weight.reshape(n_blocks, PEER_TOKEN_BLOCK, n_sel)

    def block(args):
        xb, eb, wb = args
        act = jax.nn.gelu(jnp.einsum("td,tkd->tk", xb, u_tab[eb]), approximate=False) * wb
        return jnp.einsum("tk,tkd->td", act, v_tab[eb])

    y = lax.map(block, (u_blk, e_blk, w_blk))
    return y.reshape(bsz, t, dim)


def setup_inputs(seed: int = 0) -> dict:
    key = jax.random.key(seed)
    ks = jax.random.split(key, 25)
    f32 = jnp.float32
    d = D_MODEL

    def nrm(k, shape, s):
        return s * jax.random.normal(k, shape, f32)

    a0 = jax.random.uniform(ks[14], (DEPTH, 2, RG_WIDTH), f32, 0.9, 0.999)
    sig = a0 ** (1.0 / RG_C)
    rg_lambda = jnp.log(sig) - jnp.log1p(-sig)
    blk = RG_WIDTH // RG_BLOCKS
    return {
        "x": nrm(ks[0], (BATCH, SEQ, d), 1.0),
        "c": nrm(ks[1], (BATCH, d), 1.0),
        "ctx": nrm(ks[2], (BATCH, CTX_LEN, d), 1.0),
        "c_ctx": nrm(ks[3], (d,), 1.0),
        "ada_w": nrm(ks[4], (DEPTH, d, N_MOD * d), 0.3 * d ** -0.5),
        "ada_b": nrm(ks[5], (DEPTH, N_MOD * d), 0.02),
        "norm1_g": 1.0 + nrm(ks[6], (DEPTH, d), 0.05),
        "w_in": nrm(ks[7], (DEPTH, d, IN_COLS), d ** -0.5),
        "conv_w": nrm(ks[8], (DEPTH, CONV_W, RG_WIDTH), 0.5),
        "conv_b": nrm(ks[9], (DEPTH, RG_WIDTH), 0.02),
        "rg_w_a": nrm(ks[10], (DEPTH, 2, RG_BLOCKS, blk, blk), blk ** -0.5),
        "rg_b_a": nrm(ks[11], (DEPTH, 2, RG_WIDTH), 0.1),
        "rg_w_x": nrm(ks[12], (DEPTH, 2, RG_BLOCKS, blk, blk), blk ** -0.5),
        "rg_b_x": nrm(ks[13], (DEPTH, 2, RG_WIDTH), 0.1),
        "rg_lambda": rg_lambda,
        "gla_w_g": nrm(ks[15], (DEPTH, 2, GLA_RANK, GLA_HEADS * GLA_DK), GLA_RANK ** -0.5),
        "gla_b_g": 2.0 + nrm(ks[16], (DEPTH, 2, GLA_HEADS * GLA_DK), 0.5),
        "gla_norm_g": 1.0 + nrm(ks[17], (DEPTH, GLA_DV), 0.05),
        "w_out": nrm(ks[18], (DEPTH, MIX_WIDTH, d), MIX_WIDTH ** -0.5),
        "norm2_g": 1.0 + nrm(ks[19], (DEPTH, d), 0.05),
        "peer_w_q": nrm(ks[20], (DEPTH, d, PEER_HEADS * PEER_DQ), d ** -0.5),
        "peer_keys": nrm(ks[21], (DEPTH, PEER_HEADS, 2, N_KEYS, PEER_DQ // 2), (PEER_DQ // 2) ** -0.5),
        "peer_u": nrm(ks[22], (DEPTH, N_EXPERTS, d), d ** -0.5),
        "peer_v": nrm(ks[23], (DEPTH, N_EXPERTS, d), 1.0),
        "final_norm_g": 1.0 + nrm(ks[24], (d,), 0.05),
    }


def reference(x, c, ctx, c_ctx, ada_w, ada_b, norm1_g, w_in, conv_w, conv_b, rg_w_a, rg_b_a, rg_w_x, rg_b_x, rg_lambda, gla_w_g, gla_b_g, gla_norm_g, w_out, norm2_g, peer_w_q, peer_keys, peer_u, peer_v, final_norm_g):
    bsz, n_lat, dim = x.shape
    x = x + _sincos_2d(n_lat, dim, x.dtype)[None]
    for l in range(DEPTH):
        update_ctx = l < DEPTH - 1
        mod_l = (jax.nn.silu(c) @ ada_w[l] + ada_b[l]).reshape(bsz, N_MOD, 1, dim)
        mod_c = (jax.nn.silu(c_ctx) @ ada_w[l] + ada_b[l]).reshape(N_MOD, 1, 1, dim)
        h_l = _modulate(_rmsnorm(x, norm1_g[l]), mod_l[:, 0], mod_l[:, 1]) @ w_in[l]
        h_c = _modulate(_rmsnorm(ctx, norm1_g[l]), mod_c[0], mod_c[1]) @ w_in[l]
        rx_l, rgate_l, q_l, k_l, v_l, r_l, lr_l = _split_cols(h_l)
        rx_c, rgate_c, q_c, k_c, v_c, r_c, lr_c = _split_cols(h_c)
        y_c, y_l = _rglru_mixer(rx_c, rx_l, conv_w[l], conv_b[l], rg_w_a[l], rg_b_a[l], rg_w_x[l], rg_b_x[l], rg_lambda[l])
        o_c, o_l = _gla_mixer(q_c, k_c, v_c, lr_c, q_l, k_l, v_l, lr_l, gla_w_g[l], gla_b_g[l], update_ctx)
        x = x + mod_l[:, 2] * _merge_groups(y_l, rgate_l, o_l, r_l, gla_norm_g[l], w_out[l])
        u_l = _modulate(_rmsnorm(x, norm2_g[l]), mod_l[:, 3], mod_l[:, 4])
        x = x + mod_l[:, 5] * _peer(u_l, peer_w_q[l], peer_keys[l], peer_u[l], peer_v[l])
        if update_ctx:
            ctx = ctx + mod_c[2] * _merge_groups(y_c, rgate_c, o_c, r_c, gla_norm_g[l], w_out[l])
            u_c = _modulate(_rmsnorm(ctx, norm2_g[l]), mod_c[3], mod_c[4])
            ctx = ctx + mod_c[5] * _peer(u_c, peer_w_q[l], peer_keys[l], peer_u[l], peer_v[l])
    return _rmsnorm(x, final_norm_g)
```

```cpp
#include <hip/hip_runtime.h>
#include <stdint.h>
#include <cstdio>

typedef unsigned short bf16_t;

constexpr int D = 1024, NB = 16, T = 2048, TC = 256;
constexpr int NL = NB * T;
constexpr int NCX = NB * TC;
constexpr int NTOK = NL + NCX;
constexpr int INC = 2592;
constexpr int HC = 2816, HC_RX = 0, HC_K = 512, HC_V = 768, HC_LR = 1280, HC_RG = 1536, HC_Q = 2048, HC_R = 2304;
constexpr int NMODROW = 17;
constexpr int NSEL = 128;

__host__ __device__ __forceinline__ int hmap(int n) {
    if (n < 512) return HC_RX + n;
    if (n < 1024) return HC_RG + (n - 512);
    if (n < 1280) return HC_Q + (n - 1024);
    if (n < 1536) return HC_K + (n - 1280);
    if (n < 2048) return HC_V + (n - 1536);
    if (n < 2560) return HC_R + (n - 2048);
    return HC_LR + (n - 2560);
}

__device__ __forceinline__ float bf2f(bf16_t v) { return __uint_as_float(((unsigned)v) << 16); }
__device__ __forceinline__ bf16_t f2bf(float f) { unsigned u = __float_as_uint(f); u += 0x7fffu + ((u >> 16) & 1u); return (bf16_t)(u >> 16); }
__device__ __forceinline__ float sigmoidf_(float x) { return 1.0f / (1.0f + expf(-x)); }
__device__ __forceinline__ float siluf_(float x) { return x * sigmoidf_(x); }
__device__ __forceinline__ float geluf_(float x) { return 0.5f * x * (1.0f + erff(x * 0.70710678118654752f)); }
__device__ __forceinline__ float softplusf_(float x) { return x > 20.f ? x : log1pf(expf(x)); }

constexpr size_t MB = 1ull << 20;
constexpr size_t OFF_CTL = 0, CTL_ZERO_BYTES = 32 * 1024;
constexpr size_t OFF_MOD = 1 * MB;
constexpr size_t OFF_PE = 1 * MB + 512 * 1024;
constexpr size_t OFF_WINT = 2 * MB;
constexpr size_t OFF_WOUTT = 8 * MB;
constexpr size_t OFF_WST = 10 * MB;
constexpr size_t OFF_TABU = 24 * MB;
constexpr size_t OFF_TABV = 40 * MB;
constexpr size_t OFF_TSC = 56 * MB;
constexpr size_t OFF_BIG = 88 * MB;
constexpr size_t OFF_XA = OFF_BIG;
constexpr size_t SZ_XA = (size_t)NTOK * D * 2;
constexpr size_t OFF_H = OFF_XA + SZ_XA;
constexpr size_t SZ_H = (size_t)NTOK * HC * 2;
constexpr size_t OFF_Y = OFF_H + SZ_H;
constexpr size_t SZ_Y = (size_t)2 * NL * 512 * 2;
constexpr size_t OFF_O = OFF_Y + SZ_Y;
constexpr size_t SZ_O = SZ_Y;
constexpr size_t OFF_END = OFF_O + SZ_O;
constexpr size_t OFF_A2 = OFF_XA;
constexpr size_t OFF_U = OFF_H;
constexpr size_t OFF_S = OFF_U + (size_t)NL * D * 2;
static_assert(OFF_S + (size_t)NL * 2048 * 2 <= OFF_END, "overlays");
static_assert(OFF_END <= 512 * MB, "workspace");

namespace pg8 {
#define PG8_LAS __attribute__((address_space(3)))
typedef unsigned short bf16_t;
typedef short bf16x8 __attribute__((ext_vector_type(8)));
typedef float f32x4 __attribute__((ext_vector_type(4)));
typedef unsigned u32x4 __attribute__((ext_vector_type(4)));
constexpr int BM = 256, BK = 64, HALF = 128, HTB = HALF * BK * 2  , STAGE_BYTES = 8 * HTB, NXCD = 8, WGM = 8;

__host__ __device__ __forceinline__ int lds_byte(int r, int c) { const int st = (r >> 4) * 2 + (c >> 5), rr = r & 15, cc = c & 31, ob = rr * 64 + cc * 2; return st * 1024 + (ob ^ (((ob >> 9) & 1) << 5)); }
__host__ __device__ __forceinline__ void stage_rc(int b, int& R, int& C) { const int st = b / 1024, sb = b % 1024, swz = sb ^ (((sb >> 9) & 1) << 5); R = (st >> 1) * 16 + swz / 64; C = (st & 1) * 32 + (swz % 64) / 2; }
__host__ __device__ __forceinline__ int perm32(int rho) { const int n = rho >> 4, i = rho & 15; return 8 * (i >> 2) + 4 * n + (i & 3); }

struct Unit { int pm, pn; };
struct Gemm { const bf16_t* A; const bf16_t* Bt; int M, N, K; };

struct StaticOrder {
    int nM, nN, nwg, G, c;
    __host__ __device__ void init(int M, int N, int G_, int c_) { nM = M / BM; nN = N / BM; nwg = nM * nN; G = G_; c = c_; }
    __host__ __device__ bool next(int i, Unit& u) const {
        const long L = (long)i * G + c; if (L >= nwg) return false;
        int wgid = (int)L; { const int q = nwg / NXCD, r = nwg % NXCD, xcd = wgid % NXCD, off = wgid / NXCD; wgid = (xcd < r ? xcd * (q + 1) : r * (q + 1) + (xcd - r) * q) + off; }
        const int nig = WGM * nN, gid = wgid / nig, fm = gid * WGM, gsz = (nM - fm) < WGM ? (nM - fm) : WGM;
        u.pm = fm + ((wgid % nig) % gsz); u.pn = (wgid % nig) / gsz; return true;
    }
    __device__ __forceinline__ void a_ready(const Unit&) const {}
    __device__ __forceinline__ void done(const Unit&) const {}
};

__device__ __forceinline__ unsigned cvt_pk_bf16(float lo, float hi) { unsigned r; asm volatile("v_cvt_pk_bf16_f32 %0, %1, %2" : "=v"(r) : "v"(lo), "v"(hi)); return r; }
typedef float f32x2 __attribute__((ext_vector_type(2)));
__device__ __forceinline__ f32x2 gelu_pk(f32x2 v) {
    const f32x2 av = __builtin_elementwise_abs(v), d = av * 0.2316418882f + 1.0f;
    f32x2 t; t.x = __builtin_amdgcn_rcpf(d.x); t.y = __builtin_amdgcn_rcpf(d.y);
    f32x2 q = t * 0.5307027145f + (-0.7265760135f); q = q * t + 0.7107068705f; q = q * t + (-0.142248368f); q = q * t + 0.127414796f; q = q * t;
    const f32x2 s = (v * v) * (-0.72134752044f);
    f32x2 e; e.x = __builtin_amdgcn_exp2f(s.x); e.y = __builtin_amdgcn_exp2f(s.y);
    const f32x2 m = v * (q * e), r = v - m;
    f32x2 o; o.x = v.x < 0.f ? m.x : r.x; o.y = v.y < 0.f ? m.y : r.y; return o;
}

template <int ACT  > struct EpiBf16 {
    static constexpr bool PERM = true, AFTER_DRAIN = false; static_assert(ACT == 0 || ACT == 1, "EpiBf16: ACT is 0 (none) or 1 (gelu_pk)");
    bf16_t* O; int ldc; const float* bias; int split_cols; size_t split_stride; float scale0;
    __device__ __forceinline__ void operator()(const f32x4 (&acc)[2][2][4][2], const Unit& u, int wr, int wc, int fr, int fq) const {
        const int row0 = u.pm * BM + wr * 64 + fr; int colt = u.pn * BM; bf16_t* base = O;
        float sc = 1.f; if (split_cols) { const int t = colt / split_cols; base += (size_t)t * split_stride; colt -= t * split_cols; if (t == 0) sc = scale0; }
        const int col0 = colt + wc * 32 + 8 * fq, bcol0 = u.pn * BM + wc * 32 + 8 * fq;
        f32x4 bv[2][2];
#pragma unroll
        for (int bj = 0; bj < 2; ++bj)
#pragma unroll
            for (int n = 0; n < 2; ++n) bv[bj][n] = bias ? *(const f32x4*)(bias + bcol0 + bj * HALF + 4 * n) : (f32x4){0.f, 0.f, 0.f, 0.f};
#pragma unroll
        for (int ai = 0; ai < 2; ++ai)
#pragma unroll
            for (int m = 0; m < 4; ++m) { bf16_t* rowp = base + (size_t)(row0 + ai * HALF + m * 16) * ldc + col0;
#pragma unroll
                for (int bj = 0; bj < 2; ++bj) { f32x4 v0 = acc[ai][bj][m][0] + bv[bj][0], v1 = acc[ai][bj][m][1] + bv[bj][1];
                    if (ACT == 1) { f32x2 a = gelu_pk((f32x2){v0[0], v0[1]}), b = gelu_pk((f32x2){v0[2], v0[3]}), c = gelu_pk((f32x2){v1[0], v1[1]}), d = gelu_pk((f32x2){v1[2], v1[3]});
                        v0 = (f32x4){a.x, a.y, b.x, b.y}; v1 = (f32x4){c.x, c.y, d.x, d.y}; }
                    v0 = v0 * sc; v1 = v1 * sc; u32x4 w; w.x = cvt_pk_bf16(v0[0], v0[1]); w.y = cvt_pk_bf16(v0[2], v0[3]); w.z = cvt_pk_bf16(v1[0], v1[1]); w.w = cvt_pk_bf16(v1[2], v1[3]);
                    *(u32x4*)(rowp + bj * HALF) = w; } }
    }
};
template <class Epi, class Sched, bool ALIGN_EPI = false, bool SP2 = false>
__device__ __forceinline__ void gemm_phase(PG8_LAS unsigned char* lds, const Gemm g, const Sched& S, const Epi& E) {
    const int tid = threadIdx.x, wid = __builtin_amdgcn_readfirstlane(tid >> 6), lane = tid & 63, wr = wid >> 2, wc = wid & 3, fr = lane & 15, fq = lane >> 4;
    const int K = g.K, nt = K / BK;
    unsigned voffA[2], voffB[2];
#pragma unroll
    for (int i = 0; i < 2; ++i) { int R, C; stage_rc(tid * 16 + i * 8192, R, C); const int Rb = Epi::PERM ? ((R & ~31) + perm32(R & 31)) : R;
        voffA[i] = (unsigned)(R * K + C) * 2u; voffB[i] = (unsigned)(Rb * K + C) * 2u; }
    const size_t kstep = (size_t)(BK * 2);
    const size_t hstep = (size_t)HALF * K * 2;
    const size_t tstep = 2 * hstep;
    const unsigned ldsw = (unsigned)wid * 1024u;
    const int aoff = lds_byte(wr * 64 + fr, fq * 8), boff = lds_byte(wc * 32 + fr, fq * 8);
#define PG8_SA(b, h) (((b) * 2 + (h)) * HTB)
#define PG8_SB(b, h) ((4 + (b) * 2 + (h)) * HTB)
#define PG8_STAGE(bufoff, gbase, voff) do { _Pragma("unroll") for (int _i = 0; _i < 2; ++_i) \
        __builtin_amdgcn_global_load_lds((const unsigned*)((const char*)(gbase) + (voff)[_i]), (PG8_LAS unsigned*)(lds + (bufoff) + ldsw + _i * 8192), 16, 0, 0); } while (0)
#define PG8_LDA(dst, b, h) do { _Pragma("unroll") for (int m = 0; m < 4; ++m) _Pragma("unroll") for (int k = 0; k < 2; ++k) dst[m][k] = *(const PG8_LAS bf16x8*)(lds + PG8_SA(b, h) + aoff + m * 2048 + k * 1024); } while (0)
#define PG8_LDB(dst, b, h) do { _Pragma("unroll") for (int n = 0; n < 2; ++n) _Pragma("unroll") for (int k = 0; k < 2; ++k) dst[n][k] = *(const PG8_LAS bf16x8*)(lds + PG8_SB(b, h) + boff + n * 2048 + k * 1024); } while (0)
#define PG8_MMA(ai, bj, At, Bt) do { __builtin_amdgcn_s_setprio(1); _Pragma("unroll") for (int m = 0; m < 4; ++m) _Pragma("unroll") for (int n = 0; n < 2; ++n) _Pragma("unroll") for (int k = 0; k < 2; ++k) \
        acc[ai][bj][m][n] = __builtin_amdgcn_mfma_f32_16x16x32_bf16(Bt[n][k], At[m][k], acc[ai][bj][m][n], 0, 0, 0); __builtin_amdgcn_s_setprio(0); } while (0)
#define PG8_WAIT_V(n) asm volatile("s_waitcnt vmcnt(" #n ")" ::: "memory")
#define PG8_WAIT_L(n) asm volatile("s_waitcnt lgkmcnt(" #n ")" ::: "memory")
#define PG8_BAR __builtin_amdgcn_s_barrier()
#define PG8_SCHED __builtin_amdgcn_sched_barrier(0)
    Unit cur, nxt; int ui = 0;
    if (!S.next(0, cur)) return;
    f32x4 acc[2][2][4][2];
#pragma unroll
    for (int a = 0; a < 2; ++a)
#pragma unroll
        for (int b = 0; b < 2; ++b)
#pragma unroll
            for (int m = 0; m < 4; ++m)
#pragma unroll
                for (int n = 0; n < 2; ++n) acc[a][b][m][n] = (f32x4){0.f, 0.f, 0.f, 0.f};
    bf16x8 At[4][2], B0[2][2], B1[2][2];
    const char* cA = (const char*)g.A + (size_t)cur.pm * tstep; const char* cB = (const char*)g.Bt + (size_t)cur.pn * tstep;
    S.a_ready(cur);
    if constexpr (SP2) {
        PG8_STAGE(PG8_SB(0, 0), cB, voffB); PG8_STAGE(PG8_SB(0, 1), cB + hstep, voffB); PG8_STAGE(PG8_SA(0, 0), cA, voffA); PG8_STAGE(PG8_SA(0, 1), cA + hstep, voffA);
        if (wr == 1) PG8_BAR;
        PG8_WAIT_V(2); PG8_BAR;
        PG8_STAGE(PG8_SB(1, 0), cB + kstep, voffB); PG8_STAGE(PG8_SA(1, 0), cA + kstep, voffA); PG8_STAGE(PG8_SB(1, 1), cB + hstep + kstep, voffB);
        PG8_WAIT_V(6); PG8_BAR;
    } else {
        PG8_STAGE(PG8_SB(0, 0), cB, voffB); PG8_STAGE(PG8_SA(0, 0), cA, voffA); PG8_STAGE(PG8_SB(0, 1), cB + hstep, voffB); PG8_STAGE(PG8_SA(0, 1), cA + hstep, voffA);
        if (wr == 1) PG8_BAR;
        PG8_WAIT_V(4); PG8_BAR;
        PG8_STAGE(PG8_SB(1, 0), cB + kstep, voffB); PG8_STAGE(PG8_SA(1, 0), cA + kstep, voffA); PG8_STAGE(PG8_SB(1, 1), cB + hstep + kstep, voffB);
        PG8_WAIT_V(6); PG8_BAR;
    }
    for (;;) {
        const bool has_next = S.next(ui + 1, nxt);
        const char* nA = has_next ? (const char*)g.A + (size_t)nxt.pm * tstep : cA; const char* nB = has_next ? (const char*)g.Bt + (size_t)nxt.pn * tstep : cB;
        for (int t = 0; t < nt; t += 2) {
            const bool last = (t == nt - 2);
            const char* a1 = cA + (size_t)(t + 1) * kstep;
            const char* a2 = last ? nA : cA + (size_t)(t + 2) * kstep; const char* b2 = last ? nB : cB + (size_t)(t + 2) * kstep;
            const char* a3 = a2 + kstep; const char* b3 = b2 + kstep;
            if (last && has_next) S.a_ready(nxt);
            if constexpr (SP2) {
            PG8_LDB(B0, 0, 0); PG8_LDB(B1, 0, 1); PG8_SCHED; PG8_LDA(At, 0, 0); PG8_STAGE(PG8_SA(1, 1), a1 + hstep, voffA);
            PG8_WAIT_V(8); PG8_WAIT_L(0); PG8_BAR; PG8_MMA(0, 0, At, B0); PG8_MMA(0, 1, At, B1); PG8_BAR; PG8_SCHED;
            PG8_LDA(At, 0, 1); PG8_STAGE(PG8_SB(0, 0), b2, voffB); PG8_STAGE(PG8_SB(0, 1), b2 + hstep, voffB); PG8_STAGE(PG8_SA(0, 0), a2, voffA);
            PG8_WAIT_V(8); PG8_WAIT_L(0); PG8_BAR; PG8_MMA(1, 0, At, B0); PG8_MMA(1, 1, At, B1); PG8_BAR; PG8_SCHED;
            PG8_LDB(B0, 1, 0); PG8_LDB(B1, 1, 1); PG8_SCHED; PG8_LDA(At, 1, 0); PG8_STAGE(PG8_SA(0, 1), a2 + hstep, voffA);
            PG8_WAIT_V(8); PG8_WAIT_L(0); PG8_BAR; PG8_MMA(0, 0, At, B0); PG8_MMA(0, 1, At, B1); PG8_BAR; PG8_SCHED;
            PG8_LDA(At, 1, 1); PG8_STAGE(PG8_SB(1, 0), b3, voffB); PG8_STAGE(PG8_SB(1, 1), b3 + hstep, voffB); PG8_STAGE(PG8_SA(1, 0), a3, voffA);
            PG8_WAIT_V(8); PG8_WAIT_L(0); PG8_BAR; PG8_MMA(1, 0, At, B0); PG8_MMA(1, 1, At, B1); PG8_BAR; PG8_SCHED;
            } else {
            PG8_LDB(B0, 0, 0); PG8_SCHED; PG8_LDA(At, 0, 0); PG8_STAGE(PG8_SA(1, 1), a1 + hstep, voffA);
            PG8_WAIT_L(8); PG8_BAR; PG8_WAIT_L(0); PG8_MMA(0, 0, At, B0); PG8_BAR; PG8_SCHED;
            PG8_LDB(B1, 0, 1); PG8_STAGE(PG8_SB(0, 0), b2, voffB);
            PG8_BAR; PG8_WAIT_L(0); PG8_MMA(0, 1, At, B1); PG8_BAR;
            PG8_LDA(At, 0, 1); PG8_STAGE(PG8_SA(0, 0), a2, voffA);
            PG8_BAR; PG8_WAIT_L(0); PG8_MMA(1, 0, At, B0); PG8_BAR; PG8_SCHED;
            PG8_STAGE(PG8_SB(0, 1), b2 + hstep, voffB);
            PG8_WAIT_V(6); PG8_BAR; PG8_MMA(1, 1, At, B1); PG8_BAR;
            PG8_LDB(B0, 1, 0); PG8_SCHED; PG8_LDA(At, 1, 0); PG8_STAGE(PG8_SA(0, 1), a2 + hstep, voffA);
            PG8_WAIT_L(8); PG8_BAR; PG8_WAIT_L(0); PG8_MMA(0, 0, At, B0); PG8_BAR; PG8_SCHED;
            PG8_LDB(B1, 1, 1); PG8_STAGE(PG8_SB(1, 0), b3, voffB);
            PG8_BAR; PG8_WAIT_L(0); PG8_MMA(0, 1, At, B1); PG8_BAR;
            PG8_LDA(At, 1, 1); PG8_STAGE(PG8_SA(1, 0), a3, voffA);
            PG8_BAR; PG8_WAIT_L(0); PG8_MMA(1, 0, At, B0); PG8_BAR; PG8_SCHED;
            PG8_STAGE(PG8_SB(1, 1), b3 + hstep, voffB);
            PG8_WAIT_V(6); PG8_BAR; PG8_MMA(1, 1, At, B1); PG8_BAR;
            }
        }
        if constexpr (ALIGN_EPI) { if (wr == 0) PG8_BAR; }
        if constexpr (!Epi::AFTER_DRAIN) { E(acc, cur, wr, wc, fr, fq); S.done(cur); }
        if (!has_next) break;
#pragma unroll
        for (int a = 0; a < 2; ++a)
#pragma unroll
            for (int b = 0; b < 2; ++b)
#pragma unroll
                for (int m = 0; m < 4; ++m)
#pragma unroll
                    for (int n = 0; n < 2; ++n) acc[a][b][m][n] = (f32x4){0.f, 0.f, 0.f, 0.f};
        cur = nxt; cA = nA; cB = nB; ++ui;
        if constexpr (ALIGN_EPI) { if (wr == 1) PG8_BAR; }
    }
    PG8_WAIT_V(0);
    if constexpr (!ALIGN_EPI) { if (wr == 0) PG8_BAR; }
    PG8_BAR;
    if constexpr (Epi::AFTER_DRAIN) { E.fused(acc, cur, wr, wc, fr, fq, lds, wid, lane); S.done(cur); }
#undef PG8_SA
#undef PG8_SB
#undef PG8_STAGE
#undef PG8_LDA
#undef PG8_LDB
#undef PG8_MMA
#undef PG8_WAIT_V
#undef PG8_WAIT_L
#undef PG8_BAR
#undef PG8_SCHED
}
}
#define GAS __attribute__((address_space(1)))
#define LAS __attribute__((address_space(3)))
#define XB_TMO      128
#define XB_XCNT(j)  (256  + 64 * (j))
#define XB_XSUB(j)  (1280 + 64 * (j))
#define XB_XGEN(j)  (2304 + 64 * (j))
#define XB_TOP      3328
#define XB_TOPGEN   3392
#define XCD_BAR_WORDS 3456
#define XB_SPIN_CAP (1u << 18)

__device__ __forceinline__ unsigned xb_ld(unsigned* p)              { return __hip_atomic_load(p, __ATOMIC_RELAXED, __HIP_MEMORY_SCOPE_AGENT); }
__device__ __forceinline__ unsigned xb_add(unsigned* p, unsigned v) { return __hip_atomic_fetch_add(p, v, __ATOMIC_RELAXED, __HIP_MEMORY_SCOPE_AGENT); }
__device__ __forceinline__ unsigned xb_xcc_id() { return (unsigned)__builtin_amdgcn_s_getreg((3 << 11) | 20) & 0xFu; }
#define XB_SPIN(cond, bar) do { unsigned _sp = 0; while (cond) { __builtin_amdgcn_s_sleep(1); \
    if ((++_sp & 255u) == 0u) { if (xb_ld(&(bar)[XB_TMO])) break; if (_sp > XB_SPIN_CAP) { atomicAdd(&(bar)[XB_TMO], 1u); break; } } } } while (0)

struct XcdBarrier {
    unsigned* bar; unsigned x;
    volatile LAS unsigned* st;
};

__device__ __forceinline__ XcdBarrier xcd_barrier_post(unsigned* bar, volatile LAS unsigned* st) {
    XcdBarrier b; b.bar = bar; b.x = xb_xcc_id(); b.st = st;
    if (threadIdx.x == 0) (void)xb_add(&bar[XB_XCNT(b.x)], 1u);
    return b;
}
__device__ __forceinline__ void xcd_barrier_complete(unsigned* bar, unsigned x, unsigned& nloc, unsigned& nx) {
    const unsigned G = gridDim.x * gridDim.y * gridDim.z;
    unsigned sum, cnt, mine, sp = 0u;
    for (;;) {
        sum = 0u; cnt = 0u; mine = 0u;
#pragma unroll
        for (unsigned j = 0; j < 16; ++j) { const unsigned c = xb_ld(&bar[XB_XCNT(j)]); sum += c; cnt += (c > 0u) ? 1u : 0u; mine = (j == x) ? c : mine; }
        if (sum == G) break;
        __builtin_amdgcn_s_sleep(1);
        if ((++sp & 255u) == 0u) { if (xb_ld(&bar[XB_TMO])) break; if (sp > XB_SPIN_CAP) { atomicAdd(&bar[XB_TMO], 1u); break; } }
    }
    nloc = mine > 0u ? mine : 1u; nx = cnt > 0u ? cnt : 1u;
}

__device__ __forceinline__ void xcd_barrier(const XcdBarrier& b) {
    asm volatile("s_waitcnt vmcnt(0)" ::: "memory");
    __syncthreads();
    if (threadIdx.x == 0) {
        unsigned* bar = b.bar;
        __builtin_amdgcn_s_waitcnt(0);
        unsigned nloc = b.st[0], nx = b.st[1];
        if (nloc == 0u) { xcd_barrier_complete(bar, b.x, nloc, nx); b.st[0] = nloc; b.st[1] = nx; }
        const unsigned old = xb_add(&bar[XB_XSUB(b.x)], 1u);
        const unsigned gen = old / nloc;
        if (old + 1u == (gen + 1u) * nloc) {
            __builtin_amdgcn_fence(__ATOMIC_RELEASE, "agent");
            asm volatile("s_waitcnt vmcnt(0)" ::: "memory");
            const unsigned og = xb_add(&bar[XB_TOP], 1u);
            const unsigned tg = og / nx;
            if (og + 1u == (tg + 1u) * nx) xb_add(&bar[XB_TOPGEN], 1u);
            else XB_SPIN(xb_ld(&bar[XB_TOPGEN]) == tg, bar);
            __builtin_amdgcn_fence(__ATOMIC_ACQUIRE, "agent");
            xb_add(&bar[XB_XGEN(b.x)], 1u);
            asm volatile("s_waitcnt vmcnt(0)" ::: "memory");
        } else {
            XB_SPIN(xb_ld(&bar[XB_XGEN(b.x)]) == gen, bar);
            __builtin_amdgcn_fence(__ATOMIC_ACQUIRE, "agent");
            asm volatile("s_waitcnt vmcnt(0)" ::: "memory");
        }
    }
    __syncthreads();
}
namespace mk {
constexpr int NWAVES = 8, NTHREADS = 512;
constexpr int RING_OFF = 0, RING_BYTES = 159744;
constexpr int LDSCTL_OFF = RING_BYTES, MISC_OFF = LDSCTL_OFF + 320;
constexpr int LDS_BYTES = 163840;
constexpr int CW_TMO = 0, CW_BAR = 4096;

typedef unsigned v4u __attribute__((ext_vector_type(4)));
typedef unsigned v2u __attribute__((ext_vector_type(2)));
typedef float f32x4 __attribute__((ext_vector_type(4)));
#define LDS_WAIT() asm volatile("s_waitcnt lgkmcnt(0)" ::: "memory")
#define VM_WAIT() asm volatile("s_waitcnt vmcnt(0)" ::: "memory")
#define WG_BAR() do { asm volatile("s_waitcnt lgkmcnt(0)" ::: "memory"); __builtin_amdgcn_s_barrier(); asm volatile("" ::: "memory"); } while (0)
__device__ __forceinline__ float fexp(float x) { return __builtin_amdgcn_exp2f(x * 1.4426950408889634f); }
__device__ __forceinline__ float fsigmoid(float x) { return __builtin_amdgcn_rcpf(1.0f + __builtin_amdgcn_exp2f(x * -1.4426950408889634f)); }
typedef __bf16 bf16x2_t __attribute__((ext_vector_type(2)));
typedef float f32x2_t __attribute__((ext_vector_type(2)));
__device__ __forceinline__ unsigned pk2(float lo, float hi) { const f32x2_t v = {lo, hi}; const bf16x2_t b = __builtin_convertvector(v, bf16x2_t); return __builtin_bit_cast(unsigned, b); }
__device__ __forceinline__ bf16_t f2bf_hw(float f) { return (bf16_t)(pk2(f, 0.f) & 0xffffu); }
__device__ __forceinline__ float wave_sum(float v) {
#pragma unroll
    for (int o = 1; o < 64; o <<= 1) v += __shfl_xor(v, o);
    return v;
}

struct Args {
    const float* in[25]; float* out; unsigned char* ws; int ph_lo, ph_hi;
};

struct Frame {
    LAS unsigned char* lds; volatile LAS unsigned* MISC;
    int tid, lane, wave, vcu, G;
};

__device__ __forceinline__ void p0_mod_pe(Frame& F, const float* c, const float* c_ctx, const float* ada_w, const float* ada_b, float* mod, float* pe) {
    LAS float* sc = (LAS float*)F.lds;
    LAS float* red = (LAS float*)(F.lds + 17 * 1024 * 4);
    for (int i = F.tid; i < 17 * 1024; i += NTHREADS) { const int r = i >> 10, k = i & 1023; const float v = r < 16 ? c[r * 1024 + k] : c_ctx[k]; sc[i] = siluf_(v); }
    __syncthreads();
    for (int cg = blockIdx.x; cg < 256; cg += F.G) {
        const int col0 = cg * 24;
        if (F.tid < 504) {
            const int col = F.tid % 24, kg = F.tid / 24;
            float acc[17];
#pragma unroll
            for (int r = 0; r < 17; ++r) acc[r] = 0.f;
#pragma unroll 7
            for (int k = kg; k < 1024; k += 21) { const float w = ada_w[(size_t)k * 6144 + col0 + col];
#pragma unroll
                for (int r = 0; r < 17; ++r) acc[r] += sc[r * 1024 + k] * w; }
#pragma unroll
            for (int r = 0; r < 17; ++r) red[(kg * 17 + r) * 24 + col] = acc[r];
        }
        __syncthreads();
        if (F.tid < 17 * 24) { const int r = F.tid / 24, col = F.tid % 24; float s = ada_b[col0 + col];
            for (int kg = 0; kg < 21; ++kg) s += red[(kg * 17 + r) * 24 + col];
            mod[r * 6144 + col0 + col] = s; }
        __syncthreads();
    }
    for (int p = blockIdx.x; p < 96; p += F.G) if (F.tid < 256) {
        const int i = F.tid; const double pos = p < 32 ? p : p - 32; const double omega = pow(10000.0, -(double)i / 256.0);
        pe[p * 512 + i] = (float)sin(pos * omega); pe[p * 512 + 256 + i] = (float)cos(pos * omega); }
}

template <bool HMAP>
__device__ __forceinline__ void p1_transpose_item(const float* W, int K, int N, bf16_t* WT, LAS float* scr, int item, int lane) {
    const int nblk = N / 32, kb = item / nblk, nb = item % nblk, k0 = 64 * kb, n0 = 32 * nb;
#pragma unroll 8
    for (int i = 0; i < 32; ++i) { const int kk = 2 * i + (lane >> 5); scr[kk * 33 + (lane & 31)] = W[(size_t)(k0 + kk) * N + n0 + (lane & 31)]; }
    LDS_WAIT(); asm volatile("" ::: "memory");
    const int cch = lane & 7; const int r0 = HMAP ? hmap(n0) : n0;
#pragma unroll
    for (int j = 0; j < 4; ++j) { const int n = (lane >> 3) + 8 * j; const LAS float* s = scr + (8 * cch) * 33 + n;
        v4u o; o.x = pk2(s[0 * 33], s[1 * 33]); o.y = pk2(s[2 * 33], s[3 * 33]); o.z = pk2(s[4 * 33], s[5 * 33]); o.w = pk2(s[6 * 33], s[7 * 33]);
        *(v4u*)(WT + (size_t)(r0 + n) * K + k0 + 8 * cch) = o; }
    LDS_WAIT(); asm volatile("" ::: "memory");
}
__device__ __forceinline__ void p1_fold_item(Frame& F, const float* w_q, const float* keys, bf16_t* WsT, int item) {
    LAS bf16_t* keysB = (LAS bf16_t*)F.lds;
    LAS bf16_t* wqB = (LAS bf16_t*)(F.lds + 128 * 136 * 2);
    const int hp = item >> 4, k0 = (item & 15) * 64;
    __syncthreads();
    for (int i = 0; i < 8; ++i) { const int idx = i * 512 + F.tid; const int key = idx >> 5, d4 = (idx & 31) * 4; const f32x4 v = *(const f32x4*)(keys + ((size_t)hp * 128 + key) * 128 + d4);
        v2u w; w.x = pk2(v.x, v.y); w.y = pk2(v.z, v.w); *(LAS v2u*)(keysB + key * 136 + d4) = w; }
    for (int i = 0; i < 4; ++i) { const int idx = i * 512 + F.tid; const int kk = idx >> 5, d4 = (idx & 31) * 4; const f32x4 v = *(const f32x4*)(w_q + (size_t)(k0 + kk) * 2048 + hp * 128 + d4);
        v2u w; w.x = pk2(v.x, v.y); w.y = pk2(v.z, v.w); *(LAS v2u*)(wqB + kk * 136 + d4) = w; }
    __syncthreads();
    const int fr = F.lane & 15, fq = F.lane >> 4, kt = F.wave;
    pg8::f32x4 acc[4];
#pragma unroll
    for (int m = 0; m < 4; ++m) acc[m] = (pg8::f32x4){0.f, 0.f, 0.f, 0.f};
#pragma unroll
    for (int ks = 0; ks < 4; ++ks) { const pg8::bf16x8 bfr = *(const LAS pg8::bf16x8*)(keysB + (16 * kt + fr) * 136 + 32 * ks + 8 * fq);
#pragma unroll
        for (int m = 0; m < 4; ++m) { const pg8::bf16x8 afr = *(const LAS pg8::bf16x8*)(wqB + (16 * m + fr) * 136 + 32 * ks + 8 * fq); acc[m] = __builtin_amdgcn_mfma_f32_16x16x32_bf16(afr, bfr, acc[m], 0, 0, 0); } }
    bf16_t* dst = WsT + (size_t)(hp * 128 + 16 * kt + fr) * 1024 + k0 + 4 * fq;
#pragma unroll
    for (int m = 0; m < 4; ++m) { v2u w; w.x = pk2(acc[m][0], acc[m][1]); w.y = pk2(acc[m][2], acc[m][3]); *(v2u*)(dst + 16 * m) = w; }
}
__device__ __forceinline__ void p1_xa_row(Frame& F, int row, const float* x, const float* ctx, const float* g1, const float* mod, const float* pe, bf16_t* xa) {
    f32x4 v[4]; int b;
    if (row < NL) { b = row >> 11; const int t = row & 2047; const f32x4* xr = (const f32x4*)(x + (size_t)row * D) + F.lane;
        const f32x4* p0 = (const f32x4*)(pe + (t >> 6) * 512) + F.lane; const f32x4* p1 = (const f32x4*)(pe + (32 + (t & 63)) * 512) + F.lane;
        v[0] = xr[0] + p0[0]; v[1] = xr[64] + p0[64]; v[2] = xr[128] + p1[0]; v[3] = xr[192] + p1[64];
    } else { b = 16; const f32x4* xr = (const f32x4*)(ctx + (size_t)(row - NL) * D) + F.lane;
#pragma unroll
        for (int j = 0; j < 4; ++j) v[j] = xr[64 * j]; }
    float s = 0.f;
#pragma unroll
    for (int j = 0; j < 4; ++j) s += (v[j].x * v[j].x + v[j].y * v[j].y) + (v[j].z * v[j].z + v[j].w * v[j].w);
    const float rs = rsqrtf(wave_sum(s) * (1.0f / D) + 1e-6f);
    const f32x4* gp = (const f32x4*)g1 + F.lane; const f32x4* shp = (const f32x4*)(mod + b * 6144) + F.lane; const f32x4* scp = (const f32x4*)(mod + b * 6144 + 1024) + F.lane;
    v2u* o8 = (v2u*)(xa + (size_t)row * D) + F.lane;
#pragma unroll
    for (int j = 0; j < 4; ++j) { const f32x4 g = gp[64 * j], sh = shp[64 * j], sc = scp[64 * j];
        const f32x4 o = v[j] * rs * g * (sc + 1.0f) + sh;
        v2u w; w.x = pk2(o.x, o.y); w.y = pk2(o.z, o.w); o8[64 * j] = w; }
}
__device__ __forceinline__ void p1_prologue(Frame& F, const Args& a) {
    const float* x = a.in[0]; const float* ctx = a.in[2]; const float* g1 = a.in[6]; const float* w_in = a.in[7]; const float* w_out = a.in[18];
    const float* w_q = a.in[20]; const float* keys = a.in[21]; const float* tab_u = a.in[22]; const float* tab_v = a.in[23];
    unsigned char* ws = a.ws;
    const float* mod = (const float*)(ws + OFF_MOD); const float* pe = (const float*)(ws + OFF_PE);
    bf16_t* xa = (bf16_t*)(ws + OFF_XA); bf16_t* WinT = (bf16_t*)(ws + OFF_WINT); bf16_t* WoutT = (bf16_t*)(ws + OFF_WOUTT); bf16_t* WsT = (bf16_t*)(ws + OFF_WST);
    bf16_t* tabU = (bf16_t*)(ws + OFF_TABU); bf16_t* tabV = (bf16_t*)(ws + OFF_TABV);
    for (int it = blockIdx.x; it < 256; it += F.G) p1_fold_item(F, w_q, keys, WsT, it);
    __syncthreads();
    LAS float* scr = (LAS float*)(F.lds + RING_OFF + F.wave * 16384);
    const int gw = F.vcu * NWAVES + F.wave, NGW = F.G * NWAVES;
    constexpr int I_IN = (D / 64) * (INC / 32), I_OUT = (D / 64) * (D / 32), I_PAD = 224;
    for (int it = gw; it < I_IN + I_OUT + I_PAD; it += NGW) {
        int r = it;
        if (r < I_IN) { p1_transpose_item<true>(w_in, D, INC, WinT, scr, r, F.lane); continue; } r -= I_IN;
        if (r < I_OUT) { p1_transpose_item<false>(w_out, D, D, WoutT, scr, r, F.lane); continue; } r -= I_OUT;
        { v4u z; z.x = 0; z.y = 0; z.z = 0; z.w = 0; v4u* dst = (v4u*)(WinT + (size_t)(HC_LR + 32 + r) * D) + F.lane; dst[0] = z; dst[64] = z; }
    }
    { const int r0 = gw * 16, b = r0 >> 11, t0 = r0 & 2047; const int l = F.lane;
      f32x4 cs[4], sh[4], p0[2];
#pragma unroll
      for (int j = 0; j < 4; ++j) { cs[j] = ((const f32x4*)g1)[l + 64 * j] * (((const f32x4*)(mod + b * 6144 + 1024))[l + 64 * j] + 1.0f); sh[j] = ((const f32x4*)(mod + b * 6144))[l + 64 * j]; }
      p0[0] = ((const f32x4*)(pe + (t0 >> 6) * 512))[l]; p0[1] = ((const f32x4*)(pe + (t0 >> 6) * 512))[l + 64];
      f32x4 va[4], vb[4];
      { const f32x4* xr = (const f32x4*)(x + (size_t)r0 * D) + l;
#pragma unroll
        for (int j = 0; j < 4; ++j) va[j] = xr[64 * j]; }
#pragma unroll 1
      for (int i = 0; i < 16; i += 2) {
#pragma unroll
          for (int hh = 0; hh < 2; ++hh) {
              const int row = r0 + i + hh, t = t0 + i + hh;
              const f32x4 q0 = ((const f32x4*)(pe + (32 + (t & 63)) * 512))[l], q1 = ((const f32x4*)(pe + (32 + (t & 63)) * 512))[l + 64];
              { const int nr = row + 1 < r0 + 16 ? row + 1 : row; const f32x4* xr = (const f32x4*)(x + (size_t)nr * D) + l;
                if (hh == 0) {
#pragma unroll
                    for (int j = 0; j < 4; ++j) vb[j] = xr[64 * j]; }
                else {
#pragma unroll
                    for (int j = 0; j < 4; ++j) va[j] = xr[64 * j]; } }
              f32x4 v[4];
              if (hh == 0) { v[0] = va[0] + p0[0]; v[1] = va[1] + p0[1]; v[2] = va[2] + q0; v[3] = va[3] + q1; } else { v[0] = vb[0] + p0[0]; v[1] = vb[1] + p0[1]; v[2] = vb[2] + q0; v[3] = vb[3] + q1; }
              float ssq = 0.f;
#pragma unroll
              for (int j = 0; j < 4; ++j) ssq += (v[j].x * v[j].x + v[j].y * v[j].y) + (v[j].z * v[j].z + v[j].w * v[j].w);
              const float rs = rsqrtf(wave_sum(ssq) * (1.0f / D) + 1e-6f);
              v2u* o8 = (v2u*)(xa + (size_t)row * D) + l;
#pragma unroll
              for (int j = 0; j < 4; ++j) { const f32x4 o = v[j] * rs * cs[j] + sh[j]; v2u w; w.x = pk2(o.x, o.y); w.y = pk2(o.z, o.w); o8[64 * j] = w; }
          }
      }
    }
    for (int row = NL + gw; row < NTOK; row += NGW) p1_xa_row(F, row, x, ctx, g1, mod, pe, xa);
    { const int l5 = F.lane & 31; f32x4 qn[8];
      { const int r = 2 * gw + (F.lane >> 5); const float* srow = (r >= 16384 ? tab_v + (size_t)(r - 16384) * 1024 : tab_u + (size_t)r * 1024) + 32 * l5;
#pragma unroll
        for (int i = 0; i < 8; ++i) qn[i] = ((const f32x4*)srow)[i]; }
#pragma unroll 1
      for (int rp = gw; rp < 16384; rp += NGW) {
        const int r = 2 * rp + (F.lane >> 5); const bool second = r >= 16384; const int row = second ? r - 16384 : r;
        f32x4 q[8];
#pragma unroll
        for (int i = 0; i < 8; ++i) q[i] = qn[i];
        { const int rpn = rp + NGW < 16384 ? rp + NGW : rp; const int rn = 2 * rpn + (F.lane >> 5); const float* srow = (rn >= 16384 ? tab_v + (size_t)(rn - 16384) * 1024 : tab_u + (size_t)rn * 1024) + 32 * l5;
#pragma unroll
          for (int i = 0; i < 8; ++i) qn[i] = ((const f32x4*)srow)[i]; }
        float m = 0.f;
#pragma unroll
        for (int i = 0; i < 8; ++i) m = fmaxf(m, fmaxf(fmaxf(fabsf(q[i].x), fabsf(q[i].y)), fmaxf(fabsf(q[i].z), fabsf(q[i].w))));
#pragma unroll
        for (int o = 1; o < 32; o <<= 1) m = fmaxf(m, __shfl_xor(m, o));
        float sc = 1.f;
        if (m > 0.f) { const int ex = (int)floorf(log2f(7.5f / m)); sc = ldexpf(1.0f, ex); if (m * sc > 7.5f) sc *= 0.5f; }
        unsigned w[6] = {0u, 0u, 0u, 0u, 0u, 0u};
#pragma unroll
        for (int j = 0; j < 32; ++j) { const float x = q[j >> 2][j & 3]; const float aq = fabsf(x) * sc;
            const float c = aq < 2.0f ? rintf(aq * 8.0f) : (aq < 4.0f ? 8.0f + rintf(aq * 4.0f) : fminf(16.0f + rintf(aq * 2.0f), 31.0f));
            const unsigned code = (unsigned)c | (x < 0.f ? 32u : 0u);
            const int pos = 6 * j, wi = pos >> 5, shb = pos & 31;
            w[wi] |= code << shb; if (shb > 26) w[wi + 1] |= code >> (32 - shb); }
        unsigned char* dst = (unsigned char*)(second ? tabV : tabU) + (size_t)(l5 >> 4) * 6291456 + (size_t)row * 384 + 24 * (l5 & 15);
        *(v2u*)dst = (v2u){w[0], w[1]}; *(v2u*)(dst + 8) = (v2u){w[2], w[3]}; *(v2u*)(dst + 16) = (v2u){w[4], w[5]};
        if (l5 == 0) ((float*)(ws + OFF_TSC))[r] = 1.0f / sc;
      }
    }
}

struct Sched1 {
    int G, c;
    __device__ bool next(int i, pg8::Unit& u) const {
        const int L = i * G + c; constexpr int NLAT = 128 * 11, NALL = NLAT + 16 * 6;
        if (L >= NALL) return false;
        if (L < NLAT) { constexpr int nM = 128, nN = 11, nwg = NLAT, q = nwg / 8;
            int wgid = (L % 8) * q + L / 8;
            const int nig = 4 * nN, gid = wgid / nig, fm = gid * 4; (void)nM;
            u.pm = fm + ((wgid % nig) % 4); u.pn = (wgid % nig) / 4;
        } else { const int r = L - NLAT; u.pm = 128 + r / 6; u.pn = r % 6; }
        return true;
    }
    __device__ __forceinline__ void a_ready(const pg8::Unit&) const {}
    __device__ __forceinline__ void done(const pg8::Unit&) const {}
};

struct StaticOrderW4 {
    int nM, nN, nwg, G, c;
    __device__ void init(int M, int N, int G_, int c_) { nM = M / pg8::BM; nN = N / pg8::BM; nwg = nM * nN; G = G_; c = c_; }
    __device__ bool next(int i, pg8::Unit& u) const {
        const long L = (long)i * G + c; if (L >= nwg) return false;
        int wgid = (int)L; { const int q = nwg / pg8::NXCD, r = nwg % pg8::NXCD, xcd = wgid % pg8::NXCD, off = wgid / pg8::NXCD; wgid = (xcd < r ? xcd * (q + 1) : r * (q + 1) + (xcd - r) * q) + off; }
        constexpr int W = 4; const int nig = W * nN, gid = wgid / nig, fm = gid * W, gsz = (nM - fm) < W ? (nM - fm) : W;
        u.pm = fm + ((wgid % nig) % gsz); u.pn = (wgid % nig) / gsz; return true;
    }
    __device__ __forceinline__ void a_ready(const pg8::Unit&) const {}
    __device__ __forceinline__ void done(const pg8::Unit&) const {}
};

struct EpiX1 {
    static constexpr bool PERM = true, AFTER_DRAIN = false;
    const float* x; const float* pe; const float* mod; bf16_t* out;
    __device__ __forceinline__ void operator()(const pg8::f32x4 (&acc)[2][2][4][2], const pg8::Unit& u, int wr, int wc, int fr, int fq) const {
        const int col0 = u.pn * 256 + wc * 32 + 8 * fq;
#pragma unroll
        for (int ai = 0; ai < 2; ++ai)
#pragma unroll
            for (int m = 0; m < 4; ++m) { const int r = u.pm * 256 + ai * 128 + wr * 64 + m * 16 + fr; const int b = r >> 11, t = r & 2047; const size_t off = (size_t)r * D;
#pragma unroll
                for (int bj = 0; bj < 2; ++bj) { const int c = col0 + bj * 128; pg8::f32x4 o[2];
#pragma unroll
                    for (int n = 0; n < 2; ++n) { const int cn = c + 4 * n;
                        const pg8::f32x4 xv = *(const pg8::f32x4*)(x + off + cn);
                        const pg8::f32x4 pv = *(const pg8::f32x4*)(cn < 512 ? pe + (t >> 6) * 512 + cn : pe + (32 + (t & 63)) * 512 + (cn - 512));
                        const pg8::f32x4 gv = *(const pg8::f32x4*)(mod + b * 6144 + 2048 + cn);
                        o[n] = xv + pv + gv * acc[ai][bj][m][n]; }
                    v4u w; w.x = pk2(o[0][0], o[0][1]); w.y = pk2(o[0][2], o[0][3]); w.z = pk2(o[1][0], o[1][1]); w.w = pk2(o[1][2], o[1][3]);
                    *(v4u*)(out + off + c) = w; } }
    }
};
typedef _Float16 h16x2_t __attribute__((ext_vector_type(2)));
__device__ __forceinline__ unsigned pkh2(float lo, float hi) { h16x2_t h; h.x = (_Float16)lo; h.y = (_Float16)hi; return __builtin_bit_cast(unsigned, h); }
struct EpiS {
    static constexpr bool PERM = true, AFTER_DRAIN = false;
    unsigned short* s;
    __device__ __forceinline__ void operator()(const pg8::f32x4 (&acc)[2][2][4][2], const pg8::Unit& u, int wr, int wc, int fr, int fq) const {
        const int col0 = u.pn * 256 + wc * 32 + 8 * fq;
#pragma unroll
        for (int ai = 0; ai < 2; ++ai)
#pragma unroll
            for (int m = 0; m < 4; ++m) { const int r = u.pm * 256 + ai * 128 + wr * 64 + m * 16 + fr; unsigned short* rowp = s + (size_t)r * 2048 + col0;
#pragma unroll
                for (int bj = 0; bj < 2; ++bj) { const pg8::f32x4 v0 = acc[ai][bj][m][0], v1 = acc[ai][bj][m][1];
                    v4u w; w.x = pkh2(v0[0], v0[1]); w.y = pkh2(v0[2], v0[3]); w.z = pkh2(v1[0], v1[1]); w.w = pkh2(v1[2], v1[3]); *(v4u*)(rowp + bj * 128) = w; } }
    }
};

__device__ __forceinline__ void unpack8(const v4u w, float (&f)[8]) {
    f[0] = __uint_as_float(w.x << 16); f[1] = __uint_as_float(w.x & 0xffff0000u); f[2] = __uint_as_float(w.y << 16); f[3] = __uint_as_float(w.y & 0xffff0000u);
    f[4] = __uint_as_float(w.z << 16); f[5] = __uint_as_float(w.z & 0xffff0000u); f[6] = __uint_as_float(w.w << 16); f[7] = __uint_as_float(w.w & 0xffff0000u);
}
__device__ __forceinline__ void p4_merge(Frame& F, const bf16_t* h, const bf16_t* y, const bf16_t* o, const float* gng, bf16_t* a2) {
    const int gw0 = F.vcu * NWAVES + F.wave, gw = (gw0 >> 8) * 4096 + (gw0 & 255), NGW = 256, l = F.lane;
    float gn[8];
#pragma unroll
    for (int e = 0; e < 8; ++e) gn[e] = gng[(8 * l + e) & 127];
    for (int rk = 0; rk < 16; ++rk) { const int row = gw + rk * NGW;
        const bf16_t* hr = h + (size_t)row * HC;
        float yf[8], yb[8], gt[8], of[8], ob[8], rr[8];
        unpack8(*(const v4u*)(y + (size_t)row * 512 + 8 * l), yf); unpack8(*(const v4u*)(y + ((size_t)NL + row) * 512 + 8 * l), yb);
        unpack8(*(const v4u*)(hr + HC_RG + 8 * l), gt);
        unpack8(*(const v4u*)(o + (size_t)row * 512 + 8 * l), of); unpack8(*(const v4u*)(o + ((size_t)NL + row) * 512 + 8 * l), ob);
        unpack8(*(const v4u*)(hr + HC_R + 8 * l), rr);
        float a[8], ss = 0.f;
#pragma unroll
        for (int e = 0; e < 8; e += 2) { pg8::f32x2 g2 = pg8::gelu_pk((pg8::f32x2){gt[e], gt[e + 1]}); a[e] = (yf[e] + yb[e]) * g2.x; a[e + 1] = (yf[e + 1] + yb[e + 1]) * g2.y; }
        v4u w; w.x = pk2(a[0], a[1]); w.y = pk2(a[2], a[3]); w.z = pk2(a[4], a[5]); w.w = pk2(a[6], a[7]);
        *(v4u*)(a2 + (size_t)row * D + 8 * l) = w;
#pragma unroll
        for (int e = 0; e < 8; ++e) { of[e] += ob[e]; ss += of[e] * of[e]; }
        ss += __shfl_xor(ss, 1); ss += __shfl_xor(ss, 2); ss += __shfl_xor(ss, 4); ss += __shfl_xor(ss, 8);
        const float rs = rsqrtf(ss * (1.0f / 128.0f) + 1e-6f);
#pragma unroll
        for (int e = 0; e < 8; ++e) a[e] = of[e] * rs * gn[e] * siluf_(rr[e]);
        w.x = pk2(a[0], a[1]); w.y = pk2(a[2], a[3]); w.z = pk2(a[4], a[5]); w.w = pk2(a[6], a[7]);
        *(v4u*)(a2 + (size_t)row * D + 512 + 8 * l) = w;
    }
}
__device__ __forceinline__ void p6_norm2(Frame& F, const bf16_t* x1, const float* g2, const float* mod, bf16_t* u) {
    const int gw0 = F.vcu * NWAVES + F.wave, gw = (gw0 >> 8) * 4096 + (gw0 & 255), NGW = 256;
    for (int rk = 0; rk < 16; ++rk) { const int row = gw + rk * NGW;
        const int b = row >> 11; const v4u* xr = (const v4u*)(x1 + (size_t)row * D) + F.lane; float v[2][8]; float s2 = 0.f;
#pragma unroll
        for (int j = 0; j < 2; ++j) { const v4u w = xr[64 * j]; const unsigned ww[4] = {w.x, w.y, w.z, w.w};
#pragma unroll
            for (int e = 0; e < 4; ++e) { v[j][2 * e] = __uint_as_float(ww[e] << 16); v[j][2 * e + 1] = __uint_as_float(ww[e] & 0xffff0000u); s2 += v[j][2 * e] * v[j][2 * e] + v[j][2 * e + 1] * v[j][2 * e + 1]; } }
        const float rs = rsqrtf(wave_sum(s2) * (1.0f / D) + 1e-6f);
        const float* gp = g2 + 8 * F.lane; const float* shp = mod + b * 6144 + 3072 + 8 * F.lane; const float* scp = mod + b * 6144 + 4096 + 8 * F.lane;
        v4u* o8 = (v4u*)(u + (size_t)row * D) + F.lane;
#pragma unroll
        for (int j = 0; j < 2; ++j) { float o[8];
#pragma unroll
            for (int h2 = 0; h2 < 2; ++h2) { const f32x4 g = *(const f32x4*)(gp + 512 * j + 4 * h2), sh = *(const f32x4*)(shp + 512 * j + 4 * h2), sc = *(const f32x4*)(scp + 512 * j + 4 * h2);
#pragma unroll
                for (int e = 0; e < 4; ++e) o[4 * h2 + e] = v[j][4 * h2 + e] * rs * g[e] * (sc[e] + 1.0f) + sh[e]; }
            v4u w; w.x = pk2(o[0], o[1]); w.y = pk2(o[2], o[3]); w.z = pk2(o[4], o[5]); w.w = pk2(o[6], o[7]); o8[64 * j] = w; }
    }
}

__device__ __forceinline__ float dot2bf(unsigned a, unsigned b, float c) { return __builtin_amdgcn_fdot2_f32_bf16(__builtin_bit_cast(bf16x2_t, a), __builtin_bit_cast(bf16x2_t, b), c, false); }
template <int CTRL> __device__ __forceinline__ unsigned dpp_u(unsigned x) { return (unsigned)__builtin_amdgcn_update_dpp((int)x, (int)x, CTRL, 0xF, 0xF, false); }
template <int CTRL> __device__ __forceinline__ float dpp_f(float x) { return __uint_as_float(dpp_u<CTRL>(__float_as_uint(x))); }
constexpr int DPP_X1 = 0xB1, DPP_X2 = 0x4E, DPP_HM = 0x141;
__device__ __forceinline__ unsigned ord_key(float v) { const unsigned b = __float_as_uint(v); return b ^ ((unsigned)((int)b >> 31) | 0x80000000u); }
__device__ __forceinline__ unsigned umax3(unsigned a, unsigned b, unsigned c) { return max(max(a, b), c); }
constexpr int P8_WAVE_LDS = 18432, P8_TBL_OFF = 8 * P8_WAVE_LDS;

__device__ __forceinline__ float key_score(unsigned k) {
    const unsigned o = k >> 16; const unsigned hb = (o & 0x8000u) ? (o ^ 0x8000u) : (~o & 0xFFFFu);
    const unsigned short hs = (unsigned short)hb; return (float)__builtin_bit_cast(_Float16, hs);
}
struct P8Pend { unsigned e0, e1; float w0, w1, su0, su1, sv0, sv1; };
template <int N> __device__ __forceinline__ void bitonic_sort_desc(unsigned (&a)[N]) {
#pragma unroll
    for (int k = 2; k <= N; k <<= 1)
#pragma unroll
        for (int j = k >> 1; j > 0; j >>= 1)
#pragma unroll
            for (int i = 0; i < N; ++i) { const int l = i ^ j; if (l > i) { const unsigned hi = max(a[i], a[l]), lo = min(a[i], a[l]); if ((i & k) == 0) { a[i] = hi; a[l] = lo; } else { a[i] = lo; a[l] = hi; } } }
}
template <int N> __device__ __forceinline__ void oem_sort_desc(unsigned (&a)[N]) {
#pragma unroll
    for (int p = 1; p < N; p <<= 1)
#pragma unroll
        for (int k = p; k >= 1; k >>= 1)
#pragma unroll
            for (int j = k % p; j <= N - 1 - k; j += 2 * k)
#pragma unroll
                for (int i = 0; i < k; ++i) { const int x = i + j, y = i + j + k;
                    if (y < N && (x / (2 * p)) == (y / (2 * p))) { const unsigned hi = max(a[x], a[y]), lo = min(a[x], a[y]); a[x] = hi; a[y] = lo; } }
}
template <int N> __device__ __forceinline__ void bitonic_merge_desc(unsigned (&a)[N]) {
#pragma unroll
    for (int j = N >> 1; j > 0; j >>= 1)
#pragma unroll
        for (int i = 0; i < N; ++i) { const int l = i ^ j; if (l > i) { const unsigned hi = max(a[i], a[l]), lo = min(a[i], a[l]); a[i] = hi; a[l] = lo; } }
}
template <int CTRL> __device__ __forceinline__ void top16_exchange(unsigned (&t)[16]) {
    unsigned p[16];
#pragma unroll
    for (int i = 0; i < 16; ++i) p[i] = dpp_u<CTRL>(t[15 - i]);
#pragma unroll
    for (int i = 0; i < 16; ++i) t[i] = max(t[i], p[i]);
    bitonic_merge_desc<16>(t);
}
__device__ __forceinline__ void p8_route_token(const v4u (&sh)[4], const float* tsc, LAS unsigned char* wl, const LAS unsigned* tbl, int lane, P8Pend& R) {
    LAS float* l1v = (LAS float*)wl; LAS unsigned* l1i = (LAS unsigned*)(wl + 1024);
    const int g = lane >> 2, q = lane & 3;
    unsigned ka[16], kb[16];
    typedef short s16x2_t __attribute__((ext_vector_type(2)));
#pragma unroll
    for (int i = 0; i < 4; ++i) {
#pragma unroll
        for (int w = 0; w < 4; ++w) { const unsigned dd = sh[i][w];
            const s16x2_t hv = __builtin_bit_cast(s16x2_t, dd); const s16x2_t mm = hv >> 15; const unsigned ord = dd ^ (__builtin_bit_cast(unsigned, mm) | 0x80008000u);
            const int p = 8 * i + 2 * w; const unsigned klo = (ord << 16) | (unsigned)(31 - p), khi = (ord & 0xFFFF0000u) | (unsigned)(31 - (p + 1));
            if (p < 16) { ka[p] = klo; ka[p + 1] = khi; } else { kb[p - 16] = klo; kb[p - 15] = khi; } } }
    oem_sort_desc<16>(ka); oem_sort_desc<16>(kb);
#pragma unroll
    for (int i = 0; i < 16; ++i) ka[i] = max(ka[i], kb[15 - i]);
    bitonic_merge_desc<16>(ka);
    { const unsigned hq = (unsigned)(3 - q) << 5;
#pragma unroll
      for (int i = 0; i < 16; ++i) ka[i] |= hq; }
    top16_exchange<DPP_X1>(ka); top16_exchange<DPP_X2>(ka);
    { const unsigned m0 = q == 0 ? ~0u : 0u, m1 = q == 1 ? ~0u : 0u, m2 = q == 2 ? ~0u : 0u, m3 = q == 3 ? ~0u : 0u; f32x4 vv; v4u ii;
#pragma unroll
      for (int t = 0; t < 4; ++t) { const unsigned m = (ka[t] & m0) | (ka[4 + t] & m1) | (ka[8 + t] & m2) | (ka[12 + t] & m3); vv[t] = key_score(m); ii[t] = 127u - (m & 127u); }
      *(LAS f32x4*)(l1v + g * 16 + q * 4) = vv; *(LAS v4u*)(l1i + g * 16 + q * 4) = ii; }
    LDS_WAIT(); asm volatile("" ::: "memory");
    const int hd = lane >> 3, q8 = lane & 7;
    const LAS float* v1 = l1v + (2 * hd) * 16; const LAS float* v2 = l1v + (2 * hd + 1) * 16;
    unsigned ck[8];
#pragma unroll
    for (int t = 0; t < 7; ++t) { const unsigned c = tbl[t * 8 + q8]; const bool valid = c < 256u; const unsigned cc = valid ? c : 0u;
        const float sum = v1[cc >> 4] + v2[cc & 15]; ck[t] = valid ? ((ord_key(sum) & 0xFFFFFF00u) | (255u - cc)) : 0u; }
    ck[7] = 0u;
    oem_sort_desc<8>(ck);
    unsigned t16[16];
#pragma unroll
    for (int i = 0; i < 8; ++i) { t16[i] = ck[i]; t16[8 + i] = dpp_u<DPP_X1>(ck[7 - i]); }
    bitonic_merge_desc<16>(t16);
    top16_exchange<DPP_X2>(t16); top16_exchange<DPP_HM>(t16);
    const unsigned c0 = 255u - (t16[0] & 255u); const float smax = v1[c0 >> 4] + v2[c0 & 15];
    unsigned mine2[2] = {0u, 0u};
#pragma unroll
    for (int z = 0; z < 8; ++z) { const unsigned mz = q8 == z ? ~0u : 0u; mine2[0] |= t16[2 * z] & mz; mine2[1] |= t16[2 * z + 1] & mz; }
    float p[2]; unsigned e[2];
#pragma unroll
    for (int t = 0; t < 2; ++t) { const unsigned c = 255u - (mine2[t] & 255u); const unsigned i = c >> 4, j = c & 15;
        p[t] = fexp((v1[i] + v2[j]) - smax); e[t] = l1i[(2 * hd) * 16 + i] * 128u + l1i[(2 * hd + 1) * 16 + j]; }
    float ps = p[0] + p[1];
    ps += dpp_f<DPP_X1>(ps); ps += dpp_f<DPP_X2>(ps); ps += dpp_f<DPP_HM>(ps);
    const float inv = __builtin_amdgcn_rcpf(ps);
    R.e0 = e[0]; R.e1 = e[1]; R.w0 = p[0] * inv; R.w1 = p[1] * inv;
    R.su0 = tsc[e[0]]; R.su1 = tsc[e[1]]; R.sv0 = tsc[16384 + e[0]]; R.sv1 = tsc[16384 + e[1]];
    LDS_WAIT(); asm volatile("" ::: "memory");
}
__device__ __forceinline__ void p8_route_flush(const P8Pend& R, LAS unsigned char* tok, int lane) {
    v2u ve, vw; ve.x = R.e0 | (((__float_as_uint(R.su0) >> 23) & 0xFFu) << 16); ve.y = R.e1 | (((__float_as_uint(R.su1) >> 23) & 0xFFu) << 16);
    vw.x = __float_as_uint(R.w0 * R.sv0); vw.y = __float_as_uint(R.w1 * R.sv1);
    *(LAS v2u*)((LAS unsigned*)tok + 2 * lane) = ve; *(LAS v2u*)((LAS unsigned*)(tok + 512) + 2 * lane) = vw;
}
typedef unsigned v6u_t __attribute__((ext_vector_type(6)));
typedef float v32f_t __attribute__((ext_vector_type(32)));
typedef __bf16 v32bf_t __attribute__((ext_vector_type(32)));
typedef unsigned v16u_t __attribute__((ext_vector_type(16)));
__device__ __forceinline__ v16u_t p8_cvt_bf(const v4u& ra, const v2u& rb) { v6u_t x; x[0] = ra.x; x[1] = ra.y; x[2] = ra.z; x[3] = ra.w; x[4] = rb.x; x[5] = rb.y; const v32bf_t f = __builtin_amdgcn_cvt_scalef32_pk32_bf16_fp6(x, 1.0f); return __builtin_bit_cast(v16u_t, f); }
__device__ __forceinline__ v32f_t p8_cvt(const v4u& ra, const v2u& rb) { v6u_t x; x[0] = ra.x; x[1] = ra.y; x[2] = ra.z; x[3] = ra.w; x[4] = rb.x; x[5] = rb.y; return __builtin_amdgcn_cvt_scalef32_pk32_f32_fp6(x, 1.0f); }
__device__ __forceinline__ void p8a_route(Frame& F, const float* sbuf, const float* tsc) {
    LAS unsigned* tbl = (LAS unsigned*)(F.lds + P8_TBL_OFF);
    __syncthreads();
    if (F.tid == 0) { int n = 0; for (int i = 0; i < 16; ++i) for (int j = 0; j < 16; ++j) if ((i + 1) * (j + 1) <= 16) tbl[n++] = (unsigned)(i * 16 + j); for (; n < 56; ++n) tbl[n] = 0xFFFFu; }
    __syncthreads();
    LAS unsigned char* wl = F.lds + F.wave * P8_WAVE_LDS; LAS unsigned char* rscr = wl + 16384;
    const int gw0 = F.vcu * NWAVES + F.wave, gw = (gw0 >> 8) * 4096 + (gw0 & 255), NGW = 256, g = F.lane >> 2, q = F.lane & 3;
    const unsigned short* sh16 = (const unsigned short*)sbuf;
    v4u sv[4], nv[4];
    { const v4u* p = (const v4u*)(sh16 + (size_t)gw * 2048 + g * 128 + q * 32);
#pragma unroll
      for (int i = 0; i < 4; ++i) sv[i] = p[i]; }
    P8Pend PA, PB; PB.e0 = 0u; PB.e1 = 0u; PB.w0 = 0.f; PB.w1 = 0.f; PB.su0 = 0.f; PB.su1 = 0.f; PB.sv0 = 0.f; PB.sv1 = 0.f;
    for (int it = 0; it < 8; ++it) {
        const int row = gw + 2 * it * NGW, r1 = row + NGW, r2 = it < 7 ? row + 2 * NGW : row;
        { const v4u* p = (const v4u*)(sh16 + (size_t)r1 * 2048 + g * 128 + q * 32);
#pragma unroll
          for (int i = 0; i < 4; ++i) nv[i] = p[i]; }
        p8_route_token(sv, tsc, rscr, tbl, F.lane, PA);
        p8_route_flush(PB, wl + (it > 0 ? 2 * it - 1 : 0) * 1024, F.lane);
        { const v4u* p = (const v4u*)(sh16 + (size_t)r2 * 2048 + g * 128 + q * 32);
#pragma unroll
          for (int i = 0; i < 4; ++i) sv[i] = p[i]; }
        p8_route_token(nv, tsc, rscr, tbl, F.lane, PB);
        p8_route_flush(PA, wl + (2 * it) * 1024, F.lane);
    }
    p8_route_flush(PB, wl + 15 * 1024, F.lane);
    LDS_WAIT(); asm volatile("" ::: "memory");
}
__device__ __forceinline__ void p8h_load8(v4u (&Ra)[8], v2u (&Rb)[8], const unsigned char* tabh, const LAS unsigned* sel_e, int kb, int lane) {
#pragma unroll
    for (int j = 0; j < 8; ++j) { const unsigned e = sel_e[4 * (kb * 8 + j) + (lane >> 4)] & 0xFFFFu; const unsigned char* p = tabh + (size_t)e * 384 + 24 * (lane & 15); Ra[j] = *(const v4u*)p; Rb[j] = *(const v2u*)(p + 16); }
}
__device__ __forceinline__ void p8h_dot8(v4u (&Ra)[8], v2u (&Rb)[8], const unsigned (&u)[16], int kb, LAS float* act, float* part, float pt, bool first, int lane, const LAS unsigned* sel_e,
                                         const unsigned char* ntabh, const LAS unsigned* nsel, int nkb) {
    const bool b3 = lane & 8, b2 = lane & 4;
    float p[8];
#pragma unroll
    for (int j = 0; j < 8; ++j) { const v16u_t f = p8_cvt_bf(Ra[j], Rb[j]); float a0 = 0.f, a1 = 0.f;
        { const unsigned e = nsel[4 * (nkb * 8 + j) + (lane >> 4)] & 0xFFFFu; const unsigned char* pp = ntabh + (size_t)e * 384 + 24 * (lane & 15); Ra[j] = *(const v4u*)pp; Rb[j] = *(const v2u*)(pp + 16); }
#pragma unroll
        for (int i = 0; i < 8; ++i) { const unsigned w0 = f[2 * i], w1 = f[2 * i + 1]; a0 = dot2bf(w0, u[2 * i], a0); a1 = dot2bf(w1, u[2 * i + 1], a1); }
        p[j] = a0 + a1; }
    float q4[4], q2[2];
#pragma unroll
    for (int i = 0; i < 4; ++i) { const float send = b3 ? p[i] : p[i + 4], keep = b3 ? p[i + 4] : p[i]; q4[i] = keep + __shfl_xor(send, 8); }
#pragma unroll
    for (int i = 0; i < 2; ++i) { const float send = b2 ? q4[i] : q4[i + 2], keep = b2 ? q4[i + 2] : q4[i]; q2[i] = keep + __shfl_xor(send, 4); }
#pragma unroll
    for (int i = 0; i < 2; ++i) { q2[i] += dpp_f<DPP_X1>(q2[i]); q2[i] += dpp_f<DPP_X2>(q2[i]); }
    const int j = (b3 ? 4 : 0) + (b2 ? 2 : 0) + (lane & 1), kk = 4 * (kb * 8 + j) + (lane >> 4);
    float t = (lane & 1) ? q2[1] : q2[0];
    const bool owner = (lane & 2) == 0;
    if (first) { if (owner) part[kk] = t; }
    else {
        t += pt;
        const float su = __uint_as_float((sel_e[kk] >> 16) << 23);
        const float a = pg8::gelu_pk((pg8::f32x2){t * su, 0.f}).x * act[kk];
        if (owner) act[kk] = a; }
}
__device__ __forceinline__ void p8h_acc8(v4u (&Ra)[8], v2u (&Rb)[8], f32x2_t (&y)[16], int kb, const LAS float* act, int lane, const unsigned char* ntabh, const LAS unsigned* nsel, int nkb) {
#pragma unroll
    for (int j = 0; j < 8; ++j) { const float a = act[4 * (kb * 8 + j) + (lane >> 4)]; const v32f_t f = p8_cvt(Ra[j], Rb[j]);
        { const unsigned e = nsel[4 * (nkb * 8 + j) + (lane >> 4)] & 0xFFFFu; const unsigned char* pp = ntabh + (size_t)e * 384 + 24 * (lane & 15); Ra[j] = *(const v4u*)pp; Rb[j] = *(const v2u*)(pp + 16); }
#pragma unroll
        for (int i = 0; i < 16; ++i) y[i] += (f32x2_t){f[2 * i], f[2 * i + 1]} * a; }
}
struct P8Pre { v4u u0, u1, u2, u3; float pt[4]; };
__device__ __forceinline__ void p8h_prefetch(P8Pre& P, int row, const bf16_t* ubufh, const unsigned char* sbytes, bool first, int lane) {
    const v4u* up = (const v4u*)(ubufh + (size_t)row * D + 32 * (lane & 15)); P.u0 = up[0]; P.u1 = up[1]; P.u2 = up[2]; P.u3 = up[3];
    if (!first) { const float* part = (const float*)(sbytes + (size_t)row * 4096); const int j = (lane & 8 ? 4 : 0) + (lane & 4 ? 2 : 0) + (lane & 1);
#pragma unroll
        for (int kb = 0; kb < 4; ++kb) P.pt[kb] = part[4 * (kb * 8 + j) + (lane >> 4)]; }
}
__device__ __forceinline__ void p8h_u_token(v4u (&Aa)[8], v2u (&Ab)[8], v4u (&Ba)[8], v2u (&Bb)[8], int nrow, const P8Pre& P, P8Pre& NP, const bf16_t* ubufh, const unsigned char* tabUh, LAS unsigned char* tok, unsigned char* sbytes, int row, bool first, int lane,
                                            const unsigned char* ntabh, const LAS unsigned* nsel) {
    const LAS unsigned* sel_e = (const LAS unsigned*)tok; LAS float* act = (LAS float*)(tok + 512); float* part = (float*)(sbytes + (size_t)row * 4096);
    unsigned u[16];
    u[0] = P.u0.x; u[1] = P.u0.y; u[2] = P.u0.z; u[3] = P.u0.w; u[4] = P.u1.x; u[5] = P.u1.y; u[6] = P.u1.z; u[7] = P.u1.w;
    u[8] = P.u2.x; u[9] = P.u2.y; u[10] = P.u2.z; u[11] = P.u2.w; u[12] = P.u3.x; u[13] = P.u3.y; u[14] = P.u3.z; u[15] = P.u3.w;
    p8h_prefetch(NP, nrow, ubufh, sbytes, first, lane);
    p8h_dot8(Aa, Ab, u, 0, act, part, P.pt[0], first, lane, sel_e, tabUh, sel_e, 2);
    p8h_dot8(Ba, Bb, u, 1, act, part, P.pt[1], first, lane, sel_e, tabUh, sel_e, 3);
    p8h_dot8(Aa, Ab, u, 2, act, part, P.pt[2], first, lane, sel_e, ntabh, nsel, 0);
    p8h_dot8(Ba, Bb, u, 3, act, part, P.pt[3], first, lane, sel_e, ntabh, nsel, 1);
    LDS_WAIT(); asm volatile("" ::: "memory");
}
__device__ __forceinline__ void p8h_v_token(v4u (&Aa)[8], v2u (&Ab)[8], v4u (&Ba)[8], v2u (&Bb)[8], int row, int hcol, const unsigned char* tabVh, const float* mod, const float* fg, float* outbuf, const bf16_t* x1b, LAS unsigned char* tok, LAS float* ssq, int lane,
                                            const unsigned char* ntabh, const LAS unsigned* nsel) {
    const LAS unsigned* sel_e = (const LAS unsigned*)tok; const LAS float* act = (const LAS float*)(tok + 512);
    const int b = row >> 11;
    const int eo = 32 * (lane & 15) + 16 * (lane >> 5) + 8 * ((lane >> 4) & 1);
    float* orow = outbuf + (size_t)row * D + hcol + eo; const float* mg = mod + b * 6144 + 5120 + hcol + eo; const float* fgp = fg + hcol + eo;
    f32x2_t y[16];
#pragma unroll
    for (int i = 0; i < 16; ++i) y[i] = (f32x2_t){0.f, 0.f};
    f32x4 xv[2], gv[2], lo[2];
#pragma unroll
    for (int i = 0; i < 2; ++i) gv[i] = *(const f32x4*)(mg + 4 * i);
    { const v4u lb = *(const v4u*)(x1b + (size_t)row * D + eo);
      lo[0].x = __uint_as_float(lb.x << 16); lo[0].y = __uint_as_float(lb.x & 0xffff0000u); lo[0].z = __uint_as_float(lb.y << 16); lo[0].w = __uint_as_float(lb.y & 0xffff0000u);
      lo[1].x = __uint_as_float(lb.z << 16); lo[1].y = __uint_as_float(lb.z & 0xffff0000u); lo[1].z = __uint_as_float(lb.w << 16); lo[1].w = __uint_as_float(lb.w & 0xffff0000u); }
    { const v4u xb = *(const v4u*)(x1b + (size_t)row * D + hcol + eo);
      xv[0].x = __uint_as_float(xb.x << 16); xv[0].y = __uint_as_float(xb.x & 0xffff0000u); xv[0].z = __uint_as_float(xb.y << 16); xv[0].w = __uint_as_float(xb.y & 0xffff0000u);
      xv[1].x = __uint_as_float(xb.z << 16); xv[1].y = __uint_as_float(xb.z & 0xffff0000u); xv[1].z = __uint_as_float(xb.w << 16); xv[1].w = __uint_as_float(xb.w & 0xffff0000u); }
    p8h_acc8(Aa, Ab, y, 0, act, lane, tabVh, sel_e, 2);
    p8h_acc8(Ba, Bb, y, 1, act, lane, tabVh, sel_e, 3);
    p8h_acc8(Aa, Ab, y, 2, act, lane, ntabh, nsel, 0);
    p8h_acc8(Ba, Bb, y, 3, act, lane, ntabh, nsel, 1);
    f32x2_t ym[8], yq[4];
#pragma unroll
    for (int i = 0; i < 8; ++i) { const v2u rx = __builtin_amdgcn_permlane32_swap(__float_as_uint(y[i].x), __float_as_uint(y[8 + i].x), false, false), ry = __builtin_amdgcn_permlane32_swap(__float_as_uint(y[i].y), __float_as_uint(y[8 + i].y), false, false);
        ym[i].x = __uint_as_float(rx.x) + __uint_as_float(rx.y); ym[i].y = __uint_as_float(ry.x) + __uint_as_float(ry.y); }
#pragma unroll
    for (int i = 0; i < 4; ++i) { const v2u rx = __builtin_amdgcn_permlane16_swap(__float_as_uint(ym[i].x), __float_as_uint(ym[4 + i].x), false, false), ry = __builtin_amdgcn_permlane16_swap(__float_as_uint(ym[i].y), __float_as_uint(ym[4 + i].y), false, false);
        yq[i].x = __uint_as_float(rx.x) + __uint_as_float(rx.y); yq[i].y = __uint_as_float(ry.x) + __uint_as_float(ry.y); }
    f32x4 v[2]; float ss = 0.f;
#pragma unroll
    for (int i = 0; i < 2; ++i) {
        v[i].x = xv[i].x + gv[i].x * yq[2 * i].x; v[i].y = xv[i].y + gv[i].y * yq[2 * i].y; v[i].z = xv[i].z + gv[i].z * yq[2 * i + 1].x; v[i].w = xv[i].w + gv[i].w * yq[2 * i + 1].y;
        ss += (v[i].x * v[i].x + v[i].y * v[i].y) + (v[i].z * v[i].z + v[i].w * v[i].w); }
    ss = wave_sum(ss);
    if (hcol == 0) {
        if (lane == 0) *ssq = ss;
        { v4u w; w.x = pk2(v[0].x, v[0].y); w.y = pk2(v[0].z, v[0].w); w.z = pk2(v[1].x, v[1].y); w.w = pk2(v[1].z, v[1].w); *(v4u*)((bf16_t*)x1b + (size_t)row * D + eo) = w; }
    } else {
        const float rs = rsqrtf((ss + *ssq) * (1.0f / D) + 1e-6f);
#pragma unroll
        for (int i = 0; i < 2; ++i) { const f32x4 g = *(const f32x4*)(fgp + 4 * i), gl = *(const f32x4*)(fgp - hcol + 4 * i); *(f32x4*)(orow + 4 * i) = v[i] * rs * g; *(f32x4*)(orow - hcol + 4 * i) = lo[i] * rs * gl; }
    }
}
__device__ __forceinline__ void p8b_peer(Frame& F, const bf16_t* ubuf, const unsigned char* tabU, const unsigned char* tabV, const float* mod, const float* fg, float* outbuf, unsigned char* sbytes, const bf16_t* x1b) {
    LAS unsigned char* wl = F.lds + F.wave * P8_WAVE_LDS; LAS float* ssq = (LAS float*)(wl + 16384);
    const int gw0 = F.vcu * NWAVES + F.wave, gw = (gw0 >> 8) * 4096 + (gw0 & 255), NGW = 256;
    v4u Aa[8], Ba[8]; v2u Ab[8], Bb[8];
    p8h_load8(Aa, Ab, tabU, (const LAS unsigned*)wl, 0, F.lane); p8h_load8(Ba, Bb, tabU, (const LAS unsigned*)wl, 1, F.lane);
    for (int h = 0; h < 2; ++h) {
        const bf16_t* ubufh = ubuf + 512 * h; const unsigned char* tabUh = tabU + (size_t)6291456 * h; const unsigned char* tabNext = h == 0 ? tabU + 6291456 : tabV;
        P8Pre PA, PB;
        if (h) WG_BAR();
        p8h_prefetch(PA, gw, ubufh, sbytes, h == 0, F.lane);
        for (int i = 0; i < 16; i += 2) {
            const int r0 = gw + i * NGW, r1 = gw + (i + 1) * NGW, r2 = i + 2 < 16 ? gw + (i + 2) * NGW : gw;
            p8h_u_token(Aa, Ab, Ba, Bb, r1, PA, PB, ubufh, tabUh, wl + i * 1024, sbytes, r0, h == 0, F.lane, tabUh, (const LAS unsigned*)(wl + (i + 1) * 1024));
            p8h_u_token(Aa, Ab, Ba, Bb, r2, PB, PA, ubufh, tabUh, wl + (i + 1) * 1024, sbytes, r1, h == 0, F.lane, i + 2 < 16 ? tabUh : tabNext, (const LAS unsigned*)(wl + (i + 2 < 16 ? i + 2 : 0) * 1024));
        }
    }
    for (int h = 0; h < 2; ++h) { WG_BAR();
        for (int i = 0; i < 16; ++i) p8h_v_token(Aa, Ab, Ba, Bb, gw + i * NGW, 512 * h, tabV + (size_t)6291456 * h, mod, fg, outbuf, x1b, wl + i * 1024, ssq + i, F.lane,
                                                 i < 15 ? tabV + (size_t)6291456 * h : tabV + 6291456, (const LAS unsigned*)(wl + (i < 15 ? i + 1 : 0) * 1024)); }
}

struct RgGeom { size_t rowbase; int t0, len, lat; };
__device__ __forceinline__ RgGeom rg_geom(int ci, int dir, int b) {
    RgGeom r;
    if (ci < 4) { const int ck = dir ? 3 - ci : ci; r.rowbase = (size_t)NL + b * TC; r.t0 = ck * 64; r.len = TC; r.lat = 0; }
    else { const int ck = dir ? 31 - (ci - 4) : ci - 4; r.rowbase = (size_t)b * T; r.t0 = ck * 64; r.len = T; r.lat = 1; }
    return r;
}
constexpr int RG2_WB = 0, RG2_CAR = 18432, RG2_FLG = RG2_CAR + 73 * 256, RG2_WV = RG2_FLG + 320, RG2_RAWST = 160, RG2_RAWSZ = 36 * RG2_RAWST, RG2_XASZ = 32 * 144, RG2_WVSZ = RG2_RAWSZ + RG2_XASZ, RG2_END = RG2_WV + 8 * RG2_WVSZ;
static_assert(RG2_END <= RING_BYTES, "RG LDS");
typedef float f32x16_t __attribute__((ext_vector_type(16)));
struct Rg2Geom { size_t rowbase; int p0, len; };
__device__ __forceinline__ Rg2Geom rg2_geom(int k, int b) { Rg2Geom r; if (k < 8) { r.rowbase = (size_t)NL + b * TC; r.p0 = 32 * k; r.len = TC; } else { r.rowbase = (size_t)b * T; r.p0 = 32 * (k - 8); r.len = T; } return r; }
__device__ __forceinline__ void rg2_load(const bf16_t* h, int k, int dir, int b, int g, int lane, v4u (&R)[5]) {
    const Rg2Geom gm = rg2_geom(k < 72 ? k : 71, b);
#pragma unroll
    for (int j = 0; j < 5; ++j) { const int idx = lane + 64 * j, ri = idx >> 3, c8 = idx & 7, p = gm.p0 + ri - 2; const bool ok = p >= 0 && p < gm.len && ri < 36; const int tk = ok ? (dir ? gm.len - 1 - p : p) : 0;
        R[j] = *(const v4u*)(h + (gm.rowbase + tk) * HC + HC_RX + g * 64 + c8 * 8); }
}
__device__ __forceinline__ void rg2_stage(LAS unsigned char* raw, int k, int b, int lane, const v4u (&R)[5]) {
    const Rg2Geom gm = rg2_geom(k < 72 ? k : 71, b); const v4u z = (v4u){0u, 0u, 0u, 0u};
#pragma unroll
    for (int j = 0; j < 5; ++j) { const int idx = lane + 64 * j, ri = idx >> 3, c8 = idx & 7, p = gm.p0 + ri - 2; const bool ok = p >= 0 && p < gm.len;
        if (j < 4 || ri < 36) *(LAS v4u*)(raw + ri * RG2_RAWST + c8 * 16) = ok ? R[j] : z; }
}
template <bool LAT>
__device__ __forceinline__ void rg2_tile(const bf16_t* h, bf16_t* y, int k, int dir, int b, int g, int lane, LAS unsigned char* L, LAS unsigned char* wv,
                                         const float (&w4)[2][4], const float (&cb)[2], const float (&ba)[2], const float (&bx)[2], const float (&sp)[2], v4u (&R)[5]) {
    LAS unsigned char* raw = wv; LAS unsigned* XA = (LAS unsigned*)(wv + RG2_RAWSZ); const LAS bf16_t* WB = (const LAS bf16_t*)(L + RG2_WB);
    volatile LAS float* CAR = (volatile LAS float*)(L + RG2_CAR); volatile LAS unsigned* FLG = (volatile LAS unsigned*)(L + RG2_FLG);
    const int cl = lane & 31, hh = lane >> 5;
    const LAS unsigned char* rawl = raw + (4 * hh + (dir ? 1 : 0)) * RG2_RAWST + cl * 4;
#pragma unroll
    for (int gi = 0; gi < 4; ++gi) { float rv[2][7];
#pragma unroll
        for (int m = 0; m < 7; ++m) { const unsigned wd = *(const LAS unsigned*)(rawl + (8 * gi + m) * RG2_RAWST); rv[0][m] = __uint_as_float(wd << 16); rv[1][m] = __uint_as_float(wd & 0xffff0000u); }
#pragma unroll
        for (int t = 0; t < 4; ++t) { float v0 = cb[0], v1 = cb[1];
#pragma unroll
            for (int m = 0; m < 4; ++m) { v0 += w4[0][m] * rv[0][t + m]; v1 += w4[1][m] * rv[1][t + m]; }
            XA[(8 * gi + 4 * hh + t) * 36 + cl] = pk2(v0, v1); } }
    f32x16_t acc[4];
#pragma unroll
    for (int i = 0; i < 4; ++i)
#pragma unroll
        for (int r = 0; r < 16; ++r) acc[i][r] = 0.f;
#pragma unroll
    for (int ks = 0; ks < 4; ++ks) { const pg8::bf16x8 af = *(const LAS pg8::bf16x8*)((const LAS bf16_t*)XA + cl * 72 + 16 * ks + 8 * hh);
#pragma unroll
        for (int n4 = 0; n4 < 4; ++n4) { const pg8::bf16x8 bfr = *(const LAS pg8::bf16x8*)(WB + (64 * (n4 >> 1) + 2 * cl + (n4 & 1)) * 72 + 16 * ks + 8 * hh);
            acc[n4] = __builtin_amdgcn_mfma_f32_32x32x16_bf16(af, bfr, acc[n4], 0, 0, 0); } }
    float Pl[2][4], Ph[2][4], Hl[2][4], Hh[2][4], PT[2] = {1.f, 1.f}, HT[2] = {0.f, 0.f};
#pragma unroll
    for (int gi = 0; gi < 4; ++gi) { unsigned xw[4];
#pragma unroll
        for (int t = 0; t < 4; ++t) xw[t] = XA[(8 * gi + 4 * hh + t) * 36 + cl];
#pragma unroll
        for (int nb = 0; nb < 2; ++nb) { float P = 1.f, H = 0.f;
#pragma unroll
            for (int tp = 0; tp < 4; tp += 2) { const int r = 4 * gi + tp;
                const f32x2_t xc2 = nb ? (f32x2_t){__uint_as_float(xw[tp] & 0xffff0000u), __uint_as_float(xw[tp + 1] & 0xffff0000u)} : (f32x2_t){__uint_as_float(xw[tp] << 16), __uint_as_float(xw[tp + 1] << 16)};
                const f32x2_t zr = (f32x2_t){acc[nb][r], acc[nb][r + 1]} + ba[nb], zi = (f32x2_t){acc[2 + nb][r], acc[2 + nb][r + 1]} + bx[nb];
                const f32x2_t er = (f32x2_t){__builtin_amdgcn_exp2f(zr.x), __builtin_amdgcn_exp2f(zr.y)} + 1.0f, ei = (f32x2_t){__builtin_amdgcn_exp2f(zi.x), __builtin_amdgcn_exp2f(zi.y)} + 1.0f;
                const f32x2_t gr = (f32x2_t){__builtin_amdgcn_rcpf(er.x), __builtin_amdgcn_rcpf(er.y)}, gq = (f32x2_t){__builtin_amdgcn_rcpf(ei.x), __builtin_amdgcn_rcpf(ei.y)};
                const f32x2_t la = gr * sp[nb]; const f32x2_t av = (f32x2_t){__builtin_amdgcn_exp2f(la.x), __builtin_amdgcn_exp2f(la.y)}; const f32x2_t om = 1.0f - av * av;
                const f32x2_t bb = (f32x2_t){__builtin_amdgcn_sqrtf(om.x), __builtin_amdgcn_sqrtf(om.y)} * gq * xc2;
                acc[nb][r] = av.x; acc[nb][r + 1] = av.y; acc[2 + nb][r] = bb.x; acc[2 + nb][r + 1] = bb.y;
                H = av.x * H + bb.x; P *= av.x; H = av.y * H + bb.y; P *= av.y; }
            const float Pp = __shfl_xor(P, 32), Hp = __shfl_xor(H, 32);
            Pl[nb][gi] = hh ? Pp : P; Ph[nb][gi] = hh ? P : Pp; Hl[nb][gi] = hh ? Hp : H; Hh[nb][gi] = hh ? H : Hp;
            HT[nb] = Pl[nb][gi] * HT[nb] + Hl[nb][gi]; PT[nb] *= Pl[nb][gi]; HT[nb] = Ph[nb][gi] * HT[nb] + Hh[nb][gi]; PT[nb] *= Ph[nb][gi]; }
        __builtin_amdgcn_sched_barrier(0); }
    while (__builtin_amdgcn_readfirstlane((int)FLG[k]) == 0) __builtin_amdgcn_s_sleep(1);
    asm volatile("" ::: "memory");
    float c[2]; c[0] = CAR[k * 64 + 2 * cl]; c[1] = CAR[k * 64 + 2 * cl + 1];
    if (hh == 0) { CAR[(k + 1) * 64 + 2 * cl] = PT[0] * c[0] + HT[0]; CAR[(k + 1) * 64 + 2 * cl + 1] = PT[1] * c[1] + HT[1]; }
    asm volatile("s_waitcnt lgkmcnt(0)" ::: "memory");
    if (lane == 0) FLG[k + 1] = 1u;
    const Rg2Geom gm = rg2_geom(k, b);
#pragma unroll
    for (int gi = 0; gi < 4; ++gi) { float hq[2];
#pragma unroll
        for (int nb = 0; nb < 2; ++nb) { const float clo = c[nb]; const float chi = Pl[nb][gi] * clo + Hl[nb][gi]; c[nb] = Ph[nb][gi] * chi + Hh[nb][gi]; hq[nb] = hh ? chi : clo; }
#pragma unroll
        for (int t = 0; t < 4; ++t) { const int r = 4 * gi + t; hq[0] = acc[0][r] * hq[0] + acc[2][r]; hq[1] = acc[1][r] * hq[1] + acc[3][r];
            if (LAT) { const int p = gm.p0 + 8 * gi + 4 * hh + t, tok = dir ? gm.len - 1 - p : p;
                *(unsigned*)(y + ((size_t)dir * NL + gm.rowbase + tok) * 512 + g * 64 + 2 * cl) = pk2(hq[0], hq[1]); } } }
    rg2_stage(raw, k + 8, b, lane, R);
    rg2_load(h, k + 16, dir, b, g, lane, R);
}
__device__ __forceinline__ void p3_rg(Frame& F, const bf16_t* h, const float* conv_w, const float* conv_b, const float* w_a, const float* b_a, const float* w_x, const float* b_x, const float* lam, bf16_t* y) {
    LAS unsigned char* L = F.lds; LAS bf16_t* WB = (LAS bf16_t*)(L + RG2_WB); LAS unsigned char* wv = L + RG2_WV + F.wave * RG2_WVSZ;
    for (int it0 = F.vcu; it0 < 256; it0 += F.G) { const int item = ((it0 >> 3) & 1) * 128 + (2 * (it0 >> 5) + ((it0 >> 4) & 1)) * 8 + (it0 & 7);
        const int g = item & 7, b = (item >> 3) & 15, dir = item >> 7, tid = F.tid, lane = F.lane, w = F.wave;
        __syncthreads();
        for (int i = tid; i < 8192; i += NTHREADS) { const int n = i & 127, k = i >> 7;
            const float v = n < 64 ? w_a[((size_t)(dir * 8 + g) * 64 + k) * 64 + n] : w_x[((size_t)(dir * 8 + g) * 64 + k) * 64 + n - 64]; WB[n * 72 + k] = f2bf_hw(v * -1.4426950408889634f); }
        if (tid < 73) ((LAS unsigned*)(L + RG2_FLG))[tid] = tid == 0 ? 1u : 0u;
        if (tid < 64) ((LAS float*)(L + RG2_CAR))[tid] = 0.f;
        float w4[2][4], cb[2], ba[2], bx[2], sp[2];
#pragma unroll
        for (int nb = 0; nb < 2; ++nb) { const int ch = g * 64 + 2 * (lane & 31) + nb; const float c0 = conv_w[ch], c1 = conv_w[512 + ch], c2 = conv_w[1024 + ch], c3 = conv_w[1536 + ch];
            w4[nb][0] = dir ? c3 : c0; w4[nb][1] = dir ? c2 : c1; w4[nb][2] = dir ? c1 : c2; w4[nb][3] = dir ? c0 : c3; cb[nb] = conv_b[ch];
            ba[nb] = b_a[dir * 512 + ch] * -1.4426950408889634f; bx[nb] = b_x[dir * 512 + ch] * -1.4426950408889634f; sp[nb] = -8.0f * 1.4426950408889634f * softplusf_(-lam[dir * 512 + ch]); }
        v4u R[5];
        rg2_load(h, w, dir, b, g, lane, R);
        rg2_stage(wv, w, b, lane, R);
        rg2_load(h, w + 8, dir, b, g, lane, R);
        __syncthreads();
        rg2_tile<false>(h, y, w, dir, b, g, lane, L, wv, w4, cb, ba, bx, sp, R);
        for (int it = 1; it < 9; ++it) rg2_tile<true>(h, y, w + 8 * it, dir, b, g, lane, L, wv, w4, cb, ba, bx, sp, R);
    }
}

constexpr int GL_OPS = 0, GL_OPSZ = 36864  , GL_ST = 2 * GL_OPSZ  , GL_LA = GL_ST + 2 * 9216  , GL_RAW = GL_LA + 4 * 16 * 68 * 4,
              GL_RAWSZ = 6656  , GL_SUBT = GL_RAW + 4 * GL_RAWSZ  , GL_GAM = GL_SUBT + 2048  , GL_END = GL_GAM + 512;
static_assert(GL_END <= RING_BYTES, "GLA LDS");
struct GlRegs { v4u q[2], k[2], v[2], lr; };
__device__ __forceinline__ void gl_load(const bf16_t* h, int ci, int dir, int b, int hd, int dvh, int w, int lane, GlRegs& R) {
    const RgGeom gm = rg_geom(ci < 36 ? ci : 35, dir, b);
#pragma unroll
    for (int j = 0; j < 2; ++j) { const int idx = lane + 64 * j, p = 16 * w + (idx >> 3), c8 = idx & 7, tok = dir ? 63 - p : p; const bf16_t* hr = h + (gm.rowbase + gm.t0 + tok) * HC;
        R.q[j] = *(const v4u*)(hr + HC_Q + hd * 64 + c8 * 8); R.k[j] = *(const v4u*)(hr + HC_K + hd * 64 + c8 * 8); R.v[j] = *(const v4u*)(hr + HC_V + hd * 128 + dvh * 64 + c8 * 8); }
    { const int l2 = lane & 31, p = 16 * w + (l2 >> 1), hf = l2 & 1, tok = dir ? 63 - p : p; R.lr = *(const v4u*)(h + (gm.rowbase + gm.t0 + tok) * HC + HC_LR + dir * 16 + hf * 8); }
}
__device__ __forceinline__ void gl_stage(LAS unsigned char* rawp, int lane, const GlRegs& R) {
#pragma unroll
    for (int j = 0; j < 2; ++j) { *(LAS v4u*)(rawp + (lane + 64 * j) * 16) = R.q[j]; *(LAS v4u*)(rawp + 2048 + (lane + 64 * j) * 16) = R.k[j]; *(LAS v4u*)(rawp + 4096 + (lane + 64 * j) * 16) = R.v[j]; }
    if (lane < 32) *(LAS v4u*)(rawp + 6144 + lane * 16) = R.lr;
}
__device__ __forceinline__ pg8::bf16x8 pack_bf8(const pg8::f32x4& lo, const pg8::f32x4& hi) {
    v4u w; w.x = pk2(lo[0], lo[1]); w.y = pk2(lo[2], lo[3]); w.z = pk2(hi[0], hi[1]); w.w = pk2(hi[2], hi[3]); return __builtin_bit_cast(pg8::bf16x8, w);
}
typedef short s16x4_t __attribute__((ext_vector_type(4)));
__device__ __forceinline__ pg8::bf16x8 cat4(const s16x4_t a, const s16x4_t b) { return __builtin_shufflevector(a, b, 0, 1, 2, 3, 4, 5, 6, 7); }

__device__ __forceinline__ void gl_e_gates(Frame& F, int w, const pg8::bf16x8 (&wgf)[4], float bg, float (&lc)[16], LAS float* SUBT) {
    LAS unsigned char* L = F.lds; LAS float* ZL = (LAS float*)(L + GL_LA) + w * (16 * 68); const LAS bf16_t* LR = (const LAS bf16_t*)(L + GL_RAW + w * GL_RAWSZ + 6144);
    const int lane = F.lane, fr = lane & 15, fq = lane >> 4;
    pg8::bf16x8 af = *(const LAS pg8::bf16x8*)(LR + fr * 16 + 8 * (fq & 1));
    if (fq >= 2) af = (pg8::bf16x8){0, 0, 0, 0, 0, 0, 0, 0};
#pragma unroll
    for (int nt = 0; nt < 4; ++nt) { pg8::f32x4 z = (pg8::f32x4){0.f, 0.f, 0.f, 0.f}; z = __builtin_amdgcn_mfma_f32_16x16x32_bf16(af, wgf[nt], z, 0, 0, 0);
#pragma unroll
        for (int r = 0; r < 4; ++r) ZL[(4 * fq + r) * 68 + 16 * nt + fr] = z[r]; }
    float run = 0.f;
#pragma unroll
    for (int i = 0; i < 16; ++i) { const float zn = ZL[i * 68 + lane] + bg;
        run -= __builtin_amdgcn_logf(1.0f + __builtin_amdgcn_exp2f(zn)) * (1.0f / 16.0f); lc[i] = run; }
    SUBT[w * 64 + lane] = run;
}
__device__ __forceinline__ void gl_e_ops(Frame& F, int w, LAS unsigned char* ob, LAS float* GAM, const float (&lc)[16], const LAS float* SUBT) {
    LAS unsigned char* L = F.lds; LAS bf16_t* QD = (LAS bf16_t*)ob; LAS bf16_t* KI = (LAS bf16_t*)(ob + 9216); LAS bf16_t* KDT = (LAS bf16_t*)(ob + 18432); LAS bf16_t* VT = (LAS bf16_t*)(ob + 27648);
    const LAS unsigned char* rawp = L + GL_RAW + w * GL_RAWSZ;
    const LAS bf16_t* QR = (const LAS bf16_t*)rawp; const LAS bf16_t* KR = (const LAS bf16_t*)(rawp + 2048); const LAS bf16_t* VR = (const LAS bf16_t*)(rawp + 4096);
    const int dk = F.lane;
    float off = 0.f, tot = 0.f;
#pragma unroll
    for (int s2 = 0; s2 < 4; ++s2) { const float v = SUBT[s2 * 64 + dk]; tot += v; if (s2 < w) off += v; }
    if (w == 0) GAM[dk] = __builtin_amdgcn_exp2f(tot);
    unsigned kd[16], vt[16];
#pragma unroll
    for (int i = 0; i < 16; ++i) { const int p = 16 * w + i; const float bc = lc[i] + off; const float qv = bf2f(QR[i * 64 + dk]), kv = bf2f(KR[i * 64 + dk]);
        const float eb = __builtin_amdgcn_exp2f(bc); QD[p * 72 + dk] = f2bf_hw(qv * eb); kd[i] = f2bf_hw(kv * __builtin_amdgcn_rcpf(eb)); KI[p * 72 + dk] = (bf16_t)kd[i]; vt[i] = VR[i * 64 + dk]; }
#pragma unroll
    for (int hf = 0; hf < 2; ++hf) { v4u wk, wv; wk.x = kd[8 * hf + 0] | (kd[8 * hf + 1] << 16); wk.y = kd[8 * hf + 2] | (kd[8 * hf + 3] << 16); wk.z = kd[8 * hf + 4] | (kd[8 * hf + 5] << 16); wk.w = kd[8 * hf + 6] | (kd[8 * hf + 7] << 16);
        wv.x = vt[8 * hf + 0] | (vt[8 * hf + 1] << 16); wv.y = vt[8 * hf + 2] | (vt[8 * hf + 3] << 16); wv.z = vt[8 * hf + 4] | (vt[8 * hf + 5] << 16); wv.w = vt[8 * hf + 6] | (vt[8 * hf + 7] << 16);
        *(LAS v4u*)(KDT + dk * 72 + 16 * w + 8 * hf) = wk; *(LAS v4u*)(VT + dk * 72 + 16 * w + 8 * hf) = wv; }
}
__device__ __forceinline__ void gl_m_vt(Frame& F, int m, LAS unsigned char* ob) {
    LAS unsigned char* L = F.lds; LAS bf16_t* VT = (LAS bf16_t*)(ob + 27648); const LAS bf16_t* VR = (const LAS bf16_t*)(L + GL_RAW + m * GL_RAWSZ + 4096); const int dv = F.lane;
    unsigned pr[8];
#pragma unroll
    for (int i = 0; i < 8; ++i) pr[i] = (unsigned)VR[(2 * i) * 64 + dv] | ((unsigned)VR[(2 * i + 1) * 64 + dv] << 16);
    v4u w0, w1; w0.x = pr[0]; w0.y = pr[1]; w0.z = pr[2]; w0.w = pr[3]; w1.x = pr[4]; w1.y = pr[5]; w1.z = pr[6]; w1.w = pr[7];
    *(LAS v4u*)(VT + dv * 72 + 16 * m) = w0; *(LAS v4u*)(VT + dv * 72 + 16 * m + 8) = w1;
}
__device__ __forceinline__ void gl_m_out(Frame& F, int ci, int dir, int b, int hd, int dvh, int ti, const LAS unsigned char* ob, const LAS bf16_t* STr, bf16_t* o) {
    const LAS bf16_t* QD = (const LAS bf16_t*)ob; const LAS bf16_t* KI = (const LAS bf16_t*)(ob + 9216); const LAS bf16_t* VT = (const LAS bf16_t*)(ob + 27648);
    const RgGeom gm = rg_geom(ci, dir, b);
    const int lane = F.lane, fr = lane & 15, fq = lane >> 4;
    pg8::bf16x8 qf[2], kf[4][2];
#pragma unroll
    for (int ks = 0; ks < 2; ++ks) qf[ks] = *(const LAS pg8::bf16x8*)(QD + (16 * ti + fr) * 72 + 32 * ks + 8 * fq);
#pragma unroll
    for (int mj = 0; mj < 4; ++mj)
#pragma unroll
        for (int ks = 0; ks < 2; ++ks) kf[mj][ks] = *(const LAS pg8::bf16x8*)(KI + (16 * mj + fr) * 72 + 32 * ks + 8 * fq);
    pg8::bf16x8 vf[2][4];
#pragma unroll
    for (int kk = 0; kk < 2; ++kk)
#pragma unroll
        for (int j = 0; j < 4; ++j) { const LAS bf16_t* vp = VT + (16 * j + fr) * 72 + 32 * kk + 4 * fq; vf[kk][j] = cat4(*(const LAS s16x4_t*)vp, *(const LAS s16x4_t*)(vp + 16)); }
    pg8::f32x4 ct[4];
    const int thr = 16 * ti + fr - 4 * fq;
#pragma unroll
    for (int mj = 0; mj < 4; ++mj) { ct[mj] = (pg8::f32x4){0.f, 0.f, 0.f, 0.f};
#pragma unroll
        for (int ks = 0; ks < 2; ++ks) ct[mj] = __builtin_amdgcn_mfma_f32_16x16x32_bf16(kf[mj][ks], qf[ks], ct[mj], 0, 0, 0);
#pragma unroll
        for (int r = 0; r < 4; ++r) ct[mj][r] = (16 * mj + r > thr) ? 0.f : ct[mj][r]; }
    pg8::f32x4 oacc[4];
#pragma unroll
    for (int j = 0; j < 4; ++j) oacc[j] = (pg8::f32x4){0.f, 0.f, 0.f, 0.f};
#pragma unroll
    for (int kk = 0; kk < 2; ++kk) { const pg8::bf16x8 sf = pack_bf8(ct[2 * kk], ct[2 * kk + 1]);
#pragma unroll
        for (int j = 0; j < 4; ++j) oacc[j] = __builtin_amdgcn_mfma_f32_16x16x32_bf16(vf[kk][j], sf, oacc[j], 0, 0, 0); }
#pragma unroll
    for (int j = 0; j < 4; ++j) { const int dv = 16 * j + fr;
#pragma unroll
        for (int ks = 0; ks < 2; ++ks) { const pg8::bf16x8 sf = *(const LAS pg8::bf16x8*)(STr + dv * 72 + 32 * ks + 8 * fq); oacc[j] = __builtin_amdgcn_mfma_f32_16x16x32_bf16(sf, qf[ks], oacc[j], 0, 0, 0); } }
    { const int p = 16 * ti + fr, tok = dir ? 63 - p : p; bf16_t* orow = o + ((size_t)dir * NL + gm.rowbase + gm.t0 + tok) * 512 + hd * 128 + dvh * 64;
#pragma unroll
      for (int j = 0; j < 4; ++j) { v2u wv; wv.x = pk2(oacc[j][0] * 0.125f, oacc[j][1] * 0.125f); wv.y = pk2(oacc[j][2] * 0.125f, oacc[j][3] * 0.125f); *(v2u*)(orow + 16 * j + 4 * fq) = wv; } }
}
__device__ __forceinline__ void gl_m_state(Frame& F, int mt, const LAS unsigned char* ob, const LAS float* GAM, LAS bf16_t* STw, pg8::f32x4 (&sacc)[4]) {
    const LAS bf16_t* KDT = (const LAS bf16_t*)(ob + 18432); const LAS bf16_t* VT = (const LAS bf16_t*)(ob + 27648);
    const int lane = F.lane, fr = lane & 15, fq = lane >> 4;
#pragma unroll
    for (int ks = 0; ks < 2; ++ks) { const pg8::bf16x8 kf = *(const LAS pg8::bf16x8*)(KDT + (16 * mt + fr) * 72 + 32 * ks + 8 * fq);
#pragma unroll
        for (int j = 0; j < 4; ++j) { const pg8::bf16x8 vf = *(const LAS pg8::bf16x8*)(VT + (16 * j + fr) * 72 + 32 * ks + 8 * fq); sacc[j] = __builtin_amdgcn_mfma_f32_16x16x32_bf16(kf, vf, sacc[j], 0, 0, 0); } }
    float gmv[4];
#pragma unroll
    for (int r = 0; r < 4; ++r) gmv[r] = GAM[16 * mt + 4 * fq + r];
#pragma unroll
    for (int j = 0; j < 4; ++j) {
#pragma unroll
        for (int r = 0; r < 4; ++r) sacc[j][r] *= gmv[r];
        v2u wv; wv.x = pk2(sacc[j][0], sacc[j][1]); wv.y = pk2(sacc[j][2], sacc[j][3]); *(LAS v2u*)(STw + (16 * j + fr) * 72 + 16 * mt + 4 * fq) = wv; }
}
__device__ __forceinline__ void gl_e_step(Frame& F, int s, int wq, int dir, int b, int hd, int dvh, const bf16_t* h, const pg8::bf16x8 (&wgf)[4], float bg, float (&lc)[16], GlRegs& NR) {
    LAS unsigned char* L = F.lds;
    gl_e_ops(F, wq, L + GL_OPS + (s & 1) * GL_OPSZ, (LAS float*)(L + GL_GAM + (s & 1) * 256), lc, (const LAS float*)(L + GL_SUBT + (s & 1) * 1024));
    gl_stage(L + GL_RAW + wq * GL_RAWSZ, F.lane, NR); gl_load(h, s + 3, dir, b, hd, dvh, wq, F.lane, NR);
    gl_e_gates(F, wq, wgf, bg, lc, (LAS float*)(L + GL_SUBT + ((s + 1) & 1) * 1024));
}
__device__ __forceinline__ void gl_m_step(Frame& F, int s, int wq, int dir, int b, int hd, int dvh, bf16_t* o, pg8::f32x4 (&sacc)[4]) {
    LAS unsigned char* L = F.lds;
    if (s >= 5) gl_m_out(F, s - 1, dir, b, hd, dvh, wq, L + GL_OPS + ((s - 1) & 1) * GL_OPSZ, (const LAS bf16_t*)(L + GL_ST + ((s - 1) & 1) * 9216), o);
    if (s >= 1) gl_m_state(F, wq, L + GL_OPS + ((s - 1) & 1) * GL_OPSZ, (const LAS float*)(L + GL_GAM + ((s - 1) & 1) * 256), (LAS bf16_t*)(L + GL_ST + (s & 1) * 9216), sacc);
}
__device__ __forceinline__ void p3_gla(Frame& F, const bf16_t* h, const float* w_g, const float* b_g, bf16_t* o) {
    LAS unsigned char* L = F.lds;
    for (int it0 = F.vcu; it0 < 256; it0 += F.G) { const int item = ((it0 >> 3) & 1) * 128 + (2 * (it0 >> 5) + ((it0 >> 4) & 1)) * 8 + (it0 & 7);
        const int dvh = item & 1, hd = (item >> 1) & 3, b = (item >> 3) & 15, dir = item >> 7, tid = F.tid, lane = F.lane;
        const bool isE = F.wave < 4; const int wq = F.wave & 3;
        __syncthreads();
        for (int i = tid; i < 9216 / 4; i += NTHREADS) ((LAS unsigned*)(L + GL_ST))[i] = 0u;
        pg8::bf16x8 wgf[4];
        { const int fr = lane & 15, fq = lane >> 4;
#pragma unroll
          for (int j = 0; j < 4; ++j) { float t[8];
#pragma unroll
              for (int e = 0; e < 8; ++e) t[e] = fq < 2 ? w_g[(size_t)(dir * 16 + 8 * fq + e) * 256 + hd * 64 + 16 * j + fr] * -1.4426950408889634f : 0.f;
              v4u wv; wv.x = pk2(t[0], t[1]); wv.y = pk2(t[2], t[3]); wv.z = pk2(t[4], t[5]); wv.w = pk2(t[6], t[7]); wgf[j] = __builtin_bit_cast(pg8::bf16x8, wv); } }
        const float bg = b_g[dir * 256 + hd * 64 + lane] * -1.4426950408889634f;
        pg8::f32x4 sacc[4];
#pragma unroll
        for (int j = 0; j < 4; ++j) sacc[j] = (pg8::f32x4){0.f, 0.f, 0.f, 0.f};
        float lc[16];
#pragma unroll
        for (int i = 0; i < 16; ++i) lc[i] = 0.f;
        GlRegs RA, RB;
        gl_load(h, 0, dir, b, hd, dvh, wq, lane, RA); if (isE) gl_stage(L + GL_RAW + wq * GL_RAWSZ, lane, RA);
        gl_load(h, 1, dir, b, hd, dvh, wq, lane, RA); gl_load(h, 2, dir, b, hd, dvh, wq, lane, RB);
        if (isE) gl_e_gates(F, wq, wgf, bg, lc, (LAS float*)(L + GL_SUBT));
        __syncthreads();
        if (isE) {
            for (int s = 0; s < 36; s += 2) {
                gl_e_step(F, s, wq, dir, b, hd, dvh, h, wgf, bg, lc, RA); WG_BAR();
                gl_e_step(F, s + 1, wq, dir, b, hd, dvh, h, wgf, bg, lc, RB); WG_BAR();
            }
            WG_BAR();
        } else {
            for (int s = 0; s < 37; ++s) { gl_m_step(F, s, wq, dir, b, hd, dvh, o, sacc); WG_BAR(); }
        }
    }
}

__global__ void __launch_bounds__(NTHREADS, 2) mega(Args args) {
    extern __shared__ __attribute__((aligned(16))) unsigned char lds[];
    Frame F;
    F.lds = (LAS unsigned char*)lds; F.MISC = (volatile LAS unsigned*)(F.lds + MISC_OFF);
    F.tid = threadIdx.x; F.lane = F.tid & 63; F.wave = __builtin_amdgcn_readfirstlane(F.tid >> 6);
    F.G = gridDim.x; { const int bx = blockIdx.x; F.vcu = (F.G % 8 == 0) ? (bx % 8) * (F.G / 8) + bx / 8 : bx; }
    unsigned char* ws = args.ws;
    unsigned* ctl = (unsigned*)(ws + OFF_CTL);
    for (int u = F.tid; u < (LDS_BYTES - LDSCTL_OFF) / 4; u += NTHREADS) ((LAS unsigned*)(F.lds + LDSCTL_OFF))[u] = 0u;
    __syncthreads();
    XcdBarrier bar = xcd_barrier_post(ctl + CW_BAR, F.MISC + 8);
    const int lo = args.ph_lo, hi = args.ph_hi;
#define IN(k) (lo <= (k) && (k) < hi)
#define BOTH(k) (IN(k) && IN((k) + 1))
    float* mod = (float*)(ws + OFF_MOD); float* pe = (float*)(ws + OFF_PE);
    if (IN(0)) { p0_mod_pe(F, args.in[1], args.in[3], args.in[4], args.in[5], mod, pe); if (BOTH(0)) xcd_barrier(bar); }
    if (IN(1)) { { p1_prologue(F, args); __syncthreads(); } if (BOTH(1)) xcd_barrier(bar); }
    if (IN(2)) {
        pg8::Gemm g{(const bf16_t*)(ws + OFF_XA), (const bf16_t*)(ws + OFF_WINT), NTOK, HC, D};
        Sched1 S{F.G, (int)blockIdx.x};
        pg8::EpiBf16<0> E{(bf16_t*)(ws + OFF_H), HC, nullptr, 0, 0, 1.f};
        pg8::gemm_phase<pg8::EpiBf16<0>, Sched1, true, true>(F.lds + RING_OFF, g, S, E);
        if (BOTH(2)) xcd_barrier(bar);
    }
    bf16_t* hbuf = (bf16_t*)(ws + OFF_H); bf16_t* ybuf = (bf16_t*)(ws + OFF_Y); bf16_t* obuf = (bf16_t*)(ws + OFF_O); bf16_t* a2 = (bf16_t*)(ws + OFF_A2);
    bf16_t* ubuf = (bf16_t*)(ws + OFF_U); float* sbuf = (float*)(ws + OFF_S);
    if (IN(3)) { {
        p3_rg(F, hbuf, args.in[8], args.in[9], args.in[10], args.in[11], args.in[12], args.in[13], args.in[14], ybuf);
        __syncthreads();
        p3_gla(F, hbuf, args.in[15], args.in[16], obuf);
        __syncthreads(); }
        if (BOTH(3)) xcd_barrier(bar);
    }
    if (IN(4)) { p4_merge(F, hbuf, ybuf, obuf, args.in[17], a2); if (BOTH(4)) xcd_barrier(bar); }
    if (IN(5)) {
        pg8::Gemm g{a2, (const bf16_t*)(ws + OFF_WOUTT), NL, D, D};
        pg8::StaticOrder S; S.init(NL, D, F.G, (int)blockIdx.x);
        EpiX1 E{args.in[0], pe, mod, (bf16_t*)(ws + OFF_Y)};
        pg8::gemm_phase<EpiX1, pg8::StaticOrder, true, true>(F.lds + RING_OFF, g, S, E);
        if (BOTH(5)) xcd_barrier(bar);
    }
    if (IN(6)) { p6_norm2(F, (const bf16_t*)(ws + OFF_Y), args.in[19], mod, ubuf); if (BOTH(6)) xcd_barrier(bar); }
    if (IN(7)) {
        pg8::Gemm g{ubuf, (const bf16_t*)(ws + OFF_WST), NL, 2048, D};
        StaticOrderW4 S; S.init(NL, 2048, F.G, (int)blockIdx.x);
        EpiS E{(unsigned short*)sbuf};
        pg8::gemm_phase<EpiS, StaticOrderW4, true, true>(F.lds + RING_OFF, g, S, E);
        if (BOTH(7)) xcd_barrier(bar);
    }
    if (IN(8)) {
        p8a_route(F, sbuf, (const float*)(ws + OFF_TSC));
        p8b_peer(F, ubuf, (const unsigned char*)(ws + OFF_TABU), (const unsigned char*)(ws + OFF_TABV), mod, args.in[24], args.out, (unsigned char*)sbuf, (const bf16_t*)(ws + OFF_Y));
    }
#undef IN
#undef BOTH
}
}
extern "C" void kernel_launch(void* const* d_in, const int* in_sizes, int n_in, void* d_out, int out_size, void* d_ws, size_t ws_size, hipStream_t stream) {
    static int grid = 0;
    if (grid == 0) {
        if (ws_size < OFF_END || n_in != 25) { fprintf(stderr, "kernel_launch: workspace %zu < %zu or n_in %d != 25\n", ws_size, (size_t)OFF_END, n_in); grid = -1; return; }
        int dev = 0, cus = 0, per_cu = 0;
        if (hipGetDevice(&dev) != hipSuccess || hipDeviceGetAttribute(&cus, hipDeviceAttributeMultiprocessorCount, dev) != hipSuccess) { grid = -1; return; }
        if (hipFuncSetAttribute((const void*)mk::mega, hipFuncAttributeMaxDynamicSharedMemorySize, mk::LDS_BYTES) != hipSuccess) { fprintf(stderr, "kernel_launch: hipFuncSetAttribute failed\n"); grid = -1; return; }
        if (hipOccupancyMaxActiveBlocksPerMultiprocessor(&per_cu, (const void*)mk::mega, mk::NTHREADS, mk::LDS_BYTES) != hipSuccess || per_cu < 1) { fprintf(stderr, "kernel_launch: occupancy query says %d\n", per_cu); }
        (void)hipGetLastError();
        if (cus < 256) { fprintf(stderr, "kernel_launch: built for a 256-CU MI355X (one workgroup per CU, 16 tokens per wave in the PEER phases); this device reports %d CUs; nothing launched\n", cus); grid = -1; return; }
        grid = 256;
    }
    if (grid < 0) return;
    (void)hipMemsetAsync((char*)d_ws + OFF_CTL, 0, CTL_ZERO_BYTES, stream);
    mk::Args a{};
    for (int i = 0; i < 25; ++i) a.in[i] = (const float*)d_in[i];
    a.out = (float*)d_out; a.ws = (unsigned char*)d_ws; a.ph_lo = 0; a.ph_hi = 9;
    hipLaunchKernelGGL(mk::mega, dim3(grid), dim3(mk::NTHREADS), mk::LDS_BYTES, stream, a);
}
```

```cpp
#include <hip/hip_runtime.h>
#include <stdint.h>
#include <cstdio>

typedef unsigned short bf16_t;

constexpr int D = 1024, NB = 16, T = 2048, TC = 256;
constexpr int NL = NB * T;
constexpr int NCX = NB * TC;
constexpr int NTOK = NL + NCX;
constexpr int INC = 2592;
constexpr int HC = 2816, HC_RX = 0, HC_K = 512, HC_V = 768, HC_LR = 1280, HC_RG = 1536, HC_Q = 2048, HC_R = 2304;
constexpr int NMODROW = 17;
constexpr int NSEL = 128;

__host__ __device__ __forceinline__ int hmap(int n) {
    if (n < 512) return HC_RX + n;
    if (n < 1024) return HC_RG + (n - 512);
    if (n < 1280) return HC_Q + (n - 1024);
    if (n < 1536) return HC_K + (n - 1280);
    if (n < 2048) return HC_V + (n - 1536);
    if (n < 2560) return HC_R + (n - 2048);
    return HC_LR + (n - 2560);
}

__device__ __forceinline__ float bf2f(bf16_t v) { return __uint_as_float(((unsigned)v) << 16); }
__device__ __forceinline__ bf16_t f2bf(float f) { unsigned u = __float_as_uint(f); u += 0x7fffu + ((u >> 16) & 1u); return (bf16_t)(u >> 16); }
__device__ __forceinline__ float sigmoidf_(float x) { return 1.0f / (1.0f + expf(-x)); }
__device__ __forceinline__ float siluf_(float x) { return x * sigmoidf_(x); }
__device__ __forceinline__ float geluf_(float x) { return 0.5f * x * (1.0f + erff(x * 0.70710678118654752f)); }
__device__ __forceinline__ float softplusf_(float x) { return x > 20.f ? x : log1pf(expf(x)); }

constexpr size_t MB = 1ull << 20;
constexpr size_t OFF_CTL = 0, CTL_ZERO_BYTES = 32 * 1024;
constexpr size_t OFF_MOD = 1 * MB;
constexpr size_t OFF_PE = 1 * MB + 512 * 1024;
constexpr size_t OFF_WINT = 2 * MB;
constexpr size_t OFF_WOUTT = 8 * MB;
constexpr size_t OFF_WST = 10 * MB;
constexpr size_t OFF_TABU = 24 * MB;
constexpr size_t OFF_TABV = 40 * MB;
constexpr size_t OFF_TSC = 56 * MB;
constexpr size_t OFF_BIG = 88 * MB;
constexpr size_t OFF_XA = OFF_BIG;
constexpr size_t SZ_XA = (size_t)NTOK * D * 2;
constexpr size_t OFF_H = OFF_XA + SZ_XA;
constexpr size_t SZ_H = (size_t)NTOK * HC * 2;
constexpr size_t OFF_Y = OFF_H + SZ_H;
constexpr size_t SZ_Y = (size_t)2 * NL * 512 * 2;
constexpr size_t OFF_O = OFF_Y + SZ_Y;
constexpr size_t SZ_O = SZ_Y;
constexpr size_t OFF_END = OFF_O + SZ_O;
constexpr size_t OFF_A2 = OFF_XA;
constexpr size_t OFF_U = OFF_H;
constexpr size_t OFF_S = OFF_U + (size_t)NL * D * 2;
static_assert(OFF_S + (size_t)NL * 2048 * 2 <= OFF_END, "overlays");
static_assert(OFF_END <= 512 * MB, "workspace");

namespace pg8 {
#define PG8_LAS __attribute__((address_space(3)))
typedef unsigned short bf16_t;
typedef short bf16x8 __attribute__((ext_vector_type(8)));
typedef float f32x4 __attribute__((ext_vector_type(4)));
typedef unsigned u32x4 __attribute__((ext_vector_type(4)));
constexpr int BM = 256, BK = 64, HALF = 128, HTB = HALF * BK * 2  , STAGE_BYTES = 8 * HTB, NXCD = 8, WGM = 8;

__host__ __device__ __forceinline__ int lds_byte(int r, int c) { const int st = (r >> 4) * 2 + (c >> 5), rr = r & 15, cc = c & 31, ob = rr * 64 + cc * 2; return st * 1024 + (ob ^ (((ob >> 9) & 1) << 5)); }
__host__ __device__ __forceinline__ void stage_rc(int b, int& R, int& C) { const int st = b / 1024, sb = b % 1024, swz = sb ^ (((sb >> 9) & 1) << 5); R = (st >> 1) * 16 + swz / 64; C = (st & 1) * 32 + (swz % 64) / 2; }
__host__ __device__ __forceinline__ int perm32(int rho) { const int n = rho >> 4, i = rho & 15; return 8 * (i >> 2) + 4 * n + (i & 3); }

struct Unit { int pm, pn; };
struct Gemm { const bf16_t* A; const bf16_t* Bt; int M, N, K; };

struct StaticOrder {
    int nM, nN, nwg, G, c;
    __host__ __device__ void init(int M, int N, int G_, int c_) { nM = M / BM; nN = N / BM; nwg = nM * nN; G = G_; c = c_; }
    __host__ __device__ bool next(int i, Unit& u) const {
        const long L = (long)i * G + c; if (L >= nwg) return false;
        int wgid = (int)L; { const int q = nwg / NXCD, r = nwg % NXCD, xcd = wgid % NXCD, off = wgid / NXCD; wgid = (xcd < r ? xcd * (q + 1) : r * (q + 1) + (xcd - r) * q) + off; }
        const int nig = WGM * nN, gid = wgid / nig, fm = gid * WGM, gsz = (nM - fm) < WGM ? (nM - fm) : WGM;
        u.pm = fm + ((wgid % nig) % gsz); u.pn = (wgid % nig) / gsz; return true;
    }
    __device__ __forceinline__ void a_ready(const Unit&) const {}
    __device__ __forceinline__ void done(const Unit&) const {}
};

__device__ __forceinline__ unsigned cvt_pk_bf16(float lo, float hi) { unsigned r; asm volatile("v_cvt_pk_bf16_f32 %0, %1, %2" : "=v"(r) : "v"(lo), "v"(hi)); return r; }
typedef float f32x2 __attribute__((ext_vector_type(2)));
__device__ __forceinline__ f32x2 gelu_pk(f32x2 v) {
    const f32x2 av = __builtin_elementwise_abs(v), d = av * 0.2316418882f + 1.0f;
    f32x2 t; t.x = __builtin_amdgcn_rcpf(d.x); t.y = __builtin_amdgcn_rcpf(d.y);
    f32x2 q = t * 0.5307027145f + (-0.7265760135f); q = q * t + 0.7107068705f; q = q * t + (-0.142248368f); q = q * t + 0.127414796f; q = q * t;
    const f32x2 s = (v * v) * (-0.72134752044f);
    f32x2 e; e.x = __builtin_amdgcn_exp2f(s.x); e.y = __builtin_amdgcn_exp2f(s.y);
    const f32x2 m = v * (q * e), r = v - m;
    f32x2 o; o.x = v.x < 0.f ? m.x : r.x; o.y = v.y < 0.f ? m.y : r.y; return o;
}

template <int ACT  > struct EpiBf16 {
    static constexpr bool PERM = true, AFTER_DRAIN = false; static_assert(ACT == 0 || ACT == 1, "EpiBf16: ACT is 0 (none) or 1 (gelu_pk)");
    bf16_t* O; int ldc; const float* bias; int split_cols; size_t split_stride; float scale0;
    __device__ __forceinline__ void operator()(const f32x4 (&acc)[2][2][4][2], const Unit& u, int wr, int wc, int fr, int fq) const {
        const int row0 = u.pm * BM + wr * 64 + fr; int colt = u.pn * BM; bf16_t* base = O;
        float sc = 1.f; if (split_cols) { const int t = colt / split_cols; base += (size_t)t * split_stride; colt -= t * split_cols; if (t == 0) sc = scale0; }
        const int col0 = colt + wc * 32 + 8 * fq, bcol0 = u.pn * BM + wc * 32 + 8 * fq;
        f32x4 bv[2][2];
#pragma unroll
        for (int bj = 0; bj < 2; ++bj)
#pragma unroll
            for (int n = 0; n < 2; ++n) bv[bj][n] = bias ? *(const f32x4*)(bias + bcol0 + bj * HALF + 4 * n) : (f32x4){0.f, 0.f, 0.f, 0.f};
#pragma unroll
        for (int ai = 0; ai < 2; ++ai)
#pragma unroll
            for (int m = 0; m < 4; ++m) { bf16_t* rowp = base + (size_t)(row0 + ai * HALF + m * 16) * ldc + col0;
#pragma unroll
                for (int bj = 0; bj < 2; ++bj) { f32x4 v0 = acc[ai][bj][m][0] + bv[bj][0], v1 = acc[ai][bj][m][1] + bv[bj][1];
                    if (ACT == 1) { f32x2 a = gelu_pk((f32x2){v0[0], v0[1]}), b = gelu_pk((f32x2){v0[2], v0[3]}), c = gelu_pk((f32x2){v1[0], v1[1]}), d = gelu_pk((f32x2){v1[2], v1[3]});
                        v0 = (f32x4){a.x, a.y, b.x, b.y}; v1 = (f32x4){c.x, c.y, d.x, d.y}; }
                    v0 = v0 * sc; v1 = v1 * sc; u32x4 w; w.x = cvt_pk_bf16(v0[0], v0[1]); w.y = cvt_pk_bf16(v0[2], v0[3]); w.z = cvt_pk_bf16(v1[0], v1[1]); w.w = cvt_pk_bf16(v1[2], v1[3]);
                    *(u32x4*)(rowp + bj * HALF) = w; } }
    }
};
template <class Epi, class Sched, bool ALIGN_EPI = false, bool SP2 = false>
__device__ __forceinline__ void gemm_phase(PG8_LAS unsigned char* lds, const Gemm g, const Sched& S, const Epi& E) {
    const int tid = threadIdx.x, wid = __builtin_amdgcn_readfirstlane(tid >> 6), lane = tid & 63, wr = wid >> 2, wc = wid & 3, fr = lane & 15, fq = lane >> 4;
    const int K = g.K, nt = K / BK;
    unsigned voffA[2], voffB[2];
#pragma unroll
    for (int i = 0; i < 2; ++i) { int R, C; stage_rc(tid * 16 + i * 8192, R, C); const int Rb = Epi::PERM ? ((R & ~31) + perm32(R & 31)) : R;
        voffA[i] = (unsigned)(R * K + C) * 2u; voffB[i] = (unsigned)(Rb * K + C) * 2u; }
    const size_t kstep = (size_t)(BK * 2);
    const size_t hstep = (size_t)HALF * K * 2;
    const size_t tstep = 2 * hstep;
    const unsigned ldsw = (unsigned)wid * 1024u;
    const int aoff = lds_byte(wr * 64 + fr, fq * 8), boff = lds_byte(wc * 32 + fr, fq * 8);
#define PG8_SA(b, h) (((b) * 2 + (h)) * HTB)
#define PG8_SB(b, h) ((4 + (b) * 2 + (h)) * HTB)
#define PG8_STAGE(bufoff, gbase, voff) do { _Pragma("unroll") for (int _i = 0; _i < 2; ++_i) \
        __builtin_amdgcn_global_load_lds((const unsigned*)((const char*)(gbase) + (voff)[_i]), (PG8_LAS unsigned*)(lds + (bufoff) + ldsw + _i * 8192), 16, 0, 0); } while (0)
#define PG8_LDA(dst, b, h) do { _Pragma("unroll") for (int m = 0; m < 4; ++m) _Pragma("unroll") for (int k = 0; k < 2; ++k) dst[m][k] = *(const PG8_LAS bf16x8*)(lds + PG8_SA(b, h) + aoff + m * 2048 + k * 1024); } while (0)
#define PG8_LDB(dst, b, h) do { _Pragma("unroll") for (int n = 0; n < 2; ++n) _Pragma("unroll") for (int k = 0; k < 2; ++k) dst[n][k] = *(const PG8_LAS bf16x8*)(lds + PG8_SB(b, h) + boff + n * 2048 + k * 1024); } while (0)
#define PG8_MMA(ai, bj, At, Bt) do { __builtin_amdgcn_s_setprio(1); _Pragma("unroll") for (int m = 0; m < 4; ++m) _Pragma("unroll") for (int n = 0; n < 2; ++n) _Pragma("unroll") for (int k = 0; k < 2; ++k) \
        acc[ai][bj][m][n] = __builtin_amdgcn_mfma_f32_16x16x32_bf16(Bt[n][k], At[m][k], acc[ai][bj][m][n], 0, 0, 0); __builtin_amdgcn_s_setprio(0); } while (0)
#define PG8_WAIT_V(n) asm volatile("s_waitcnt vmcnt(" #n ")" ::: "memory")
#define PG8_WAIT_L(n) asm volatile("s_waitcnt lgkmcnt(" #n ")" ::: "memory")
#define PG8_BAR __builtin_amdgcn_s_barrier()
#define PG8_SCHED __builtin_amdgcn_sched_barrier(0)
    Unit cur, nxt; int ui = 0;
    if (!S.next(0, cur)) return;
    f32x4 acc[2][2][4][2];
#pragma unroll
    for (int a = 0; a < 2; ++a)
#pragma unroll
        for (int b = 0; b < 2; ++b)
#pragma unroll
            for (int m = 0; m < 4; ++m)
#pragma unroll
                for (int n = 0; n < 2; ++n) acc[a][b][m][n] = (f32x4){0.f, 0.f, 0.f, 0.f};
    bf16x8 At[4][2], B0[2][2], B1[2][2];
    const char* cA = (const char*)g.A + (size_t)cur.pm * tstep; const char* cB = (const char*)g.Bt + (size_t)cur.pn * tstep;
    S.a_ready(cur);
    if constexpr (SP2) {
        PG8_STAGE(PG8_SB(0, 0), cB, voffB); PG8_STAGE(PG8_SB(0, 1), cB + hstep, voffB); PG8_STAGE(PG8_SA(0, 0), cA, voffA); PG8_STAGE(PG8_SA(0, 1), cA + hstep, voffA);
        if (wr == 1) PG8_BAR;
        PG8_WAIT_V(2); PG8_BAR;
        PG8_STAGE(PG8_SB(1, 0), cB + kstep, voffB); PG8_STAGE(PG8_SA(1, 0), cA + kstep, voffA); PG8_STAGE(PG8_SB(1, 1), cB + hstep + kstep, voffB);
        PG8_WAIT_V(6); PG8_BAR;
    } else {
        PG8_STAGE(PG8_SB(0, 0), cB, voffB); PG8_STAGE(PG8_SA(0, 0), cA, voffA); PG8_STAGE(PG8_SB(0, 1), cB + hstep, voffB); PG8_STAGE(PG8_SA(0, 1), cA + hstep, voffA);
        if (wr == 1) PG8_BAR;
        PG8_WAIT_V(4); PG8_BAR;
        PG8_STAGE(PG8_SB(1, 0), cB + kstep, voffB); PG8_STAGE(PG8_SA(1, 0), cA + kstep, voffA); PG8_STAGE(PG8_SB(1, 1), cB + hstep + kstep, voffB);
        PG8_WAIT_V(6); PG8_BAR;
    }
    for (;;) {
        const bool has_next = S.next(ui + 1, nxt);
        const char* nA = has_next ? (const char*)g.A + (size_t)nxt.pm * tstep : cA; const char* nB = has_next ? (const char*)g.Bt + (size_t)nxt.pn * tstep : cB;
        for (int t = 0; t < nt; t += 2) {
            const bool last = (t == nt - 2);
            const char* a1 = cA + (size_t)(t + 1) * kstep;
            const char* a2 = last ? nA : cA + (size_t)(t + 2) * kstep; const char* b2 = last ? nB : cB + (size_t)(t + 2) * kstep;
            const char* a3 = a2 + kstep; const char* b3 = b2 + kstep;
            if (last && has_next) S.a_ready(nxt);
            if constexpr (SP2) {
            PG8_LDB(B0, 0, 0); PG8_LDB(B1, 0, 1); PG8_SCHED; PG8_LDA(At, 0, 0); PG8_STAGE(PG8_SA(1, 1), a1 + hstep, voffA);
            PG8_WAIT_V(8); PG8_WAIT_L(0); PG8_BAR; PG8_MMA(0, 0, At, B0); PG8_MMA(0, 1, At, B1); PG8_BAR; PG8_SCHED;
            PG8_LDA(At, 0, 1); PG8_STAGE(PG8_SB(0, 0), b2, voffB); PG8_STAGE(PG8_SB(0, 1), b2 + hstep, voffB); PG8_STAGE(PG8_SA(0, 0), a2, voffA);
            PG8_WAIT_V(8); PG8_WAIT_L(0); PG8_BAR; PG8_MMA(1, 0, At, B0); PG8_MMA(1, 1, At, B1); PG8_BAR; PG8_SCHED;
            PG8_LDB(B0, 1, 0); PG8_LDB(B1, 1, 1); PG8_SCHED; PG8_LDA(At, 1, 0); PG8_STAGE(PG8_SA(0, 1), a2 + hstep, voffA);
            PG8_WAIT_V(8); PG8_WAIT_L(0); PG8_BAR; PG8_MMA(0, 0, At, B0); PG8_MMA(0, 1, At, B1); PG8_BAR; PG8_SCHED;
            PG8_LDA(At, 1, 1); PG8_STAGE(PG8_SB(1, 0), b3, voffB); PG8_STAGE(PG8_SB(1, 1), b3 + hstep, voffB); PG8_STAGE(PG8_SA(1, 0), a3, voffA);
            PG8_WAIT_V(8); PG8_WAIT_L(0); PG8_BAR; PG8_MMA(1, 0, At, B0); PG8_MMA(1, 1, At, B1); PG8_BAR; PG8_SCHED;
            } else {
            PG8_LDB(B0, 0, 0); PG8_SCHED; PG8_LDA(At, 0, 0); PG8_STAGE(PG8_SA(1, 1), a1 + hstep, voffA);
            PG8_WAIT_L(8); PG8_BAR; PG8_WAIT_L(0); PG8_MMA(0, 0, At, B0); PG8_BAR; PG8_SCHED;
            PG8_LDB(B1, 0, 1); PG8_STAGE(PG8_SB(0, 0), b2, voffB);
            PG8_BAR; PG8_WAIT_L(0); PG8_MMA(0, 1, At, B1); PG8_BAR;
            PG8_LDA(At, 0, 1); PG8_STAGE(PG8_SA(0, 0), a2, voffA);
            PG8_BAR; PG8_WAIT_L(0); PG8_MMA(1, 0, At, B0); PG8_BAR; PG8_SCHED;
            PG8_STAGE(PG8_SB(0, 1), b2 + hstep, voffB);
            PG8_WAIT_V(6); PG8_BAR; PG8_MMA(1, 1, At, B1); PG8_BAR;
            PG8_LDB(B0, 1, 0); PG8_SCHED; PG8_LDA(At, 1, 0); PG8_STAGE(PG8_SA(0, 1), a2 + hstep, voffA);
            PG8_WAIT_L(8); PG8_BAR; PG8_WAIT_L(0); PG8_MMA(0, 0, At, B0); PG8_BAR; PG8_SCHED;
            PG8_LDB(B1, 1, 1); PG8_STAGE(PG8_SB(1, 0), b3, voffB);
            PG8_BAR; PG8_WAIT_L(0); PG8_MMA(0, 1, At, B1); PG8_BAR;
            PG8_LDA(At, 1, 1); PG8_STAGE(PG8_SA(1, 0), a3, voffA);
            PG8_BAR; PG8_WAIT_L(0); PG8_MMA(1, 0, At, B0); PG8_BAR; PG8_SCHED;
            PG8_STAGE(PG8_SB(1, 1), b3 + hstep, voffB);
            PG8_WAIT_V(6); PG8_BAR; PG8_MMA(1, 1, At, B1); PG8_BAR;
            }
        }
        if constexpr (ALIGN_EPI) { if (wr == 0) PG8_BAR; }
        if constexpr (!Epi::AFTER_DRAIN) { E(acc, cur, wr, wc, fr, fq); S.done(cur); }
        if (!has_next) break;
#pragma unroll
        for (int a = 0; a < 2; ++a)
#pragma unroll
            for (int b = 0; b < 2; ++b)
#pragma unroll
                for (int m = 0; m < 4; ++m)
#pragma unroll
                    for (int n = 0; n < 2; ++n) acc[a][b][m][n] = (f32x4){0.f, 0.f, 0.f, 0.f};
        cur = nxt; cA = nA; cB = nB; ++ui;
        if constexpr (ALIGN_EPI) { if (wr == 1) PG8_BAR; }
    }
    PG8_WAIT_V(0);
    if constexpr (!ALIGN_EPI) { if (wr == 0) PG8_BAR; }
    PG8_BAR;
    if constexpr (Epi::AFTER_DRAIN) { E.fused(acc, cur, wr, wc, fr, fq, lds, wid, lane); S.done(cur); }
#undef PG8_SA
#undef PG8_SB
#undef PG8_STAGE
#undef PG8_LDA
#undef PG8_LDB
#undef PG8_MMA
#undef PG8_WAIT_V
#undef PG8_WAIT_L
#undef PG8_BAR
#undef PG8_SCHED
}
}
#define GAS __attribute__((address_space(1)))
#define LAS __attribute__((address_space(3)))
#define XB_TMO      128
#define XB_XCNT(j)  (256  + 64 * (j))
#define XB_XSUB(j)  (1280 + 64 * (j))
#define XB_XGEN(j)  (2304 + 64 * (j))
#define XB_TOP      3328
#define XB_TOPGEN   3392
#define XCD_BAR_WORDS 3456
#define XB_SPIN_CAP (1u << 18)

__device__ __forceinline__ unsigned xb_ld(unsigned* p)              { return __hip_atomic_load(p, __ATOMIC_RELAXED, __HIP_MEMORY_SCOPE_AGENT); }
__device__ __forceinline__ unsigned xb_add(unsigned* p, unsigned v) { return __hip_atomic_fetch_add(p, v, __ATOMIC_RELAXED, __HIP_MEMORY_SCOPE_AGENT); }
__device__ __forceinline__ unsigned xb_xcc_id() { return (unsigned)__builtin_amdgcn_s_getreg((3 << 11) | 20) & 0xFu; }
#define XB_SPIN(cond, bar) do { unsigned _sp = 0; while (cond) { __builtin_amdgcn_s_sleep(1); \
    if ((++_sp & 255u) == 0u) { if (xb_ld(&(bar)[XB_TMO])) break; if (_sp > XB_SPIN_CAP) { atomicAdd(&(bar)[XB_TMO], 1u); break; } } } } while (0)

struct XcdBarrier {
    unsigned* bar; unsigned x;
    volatile LAS unsigned* st;
};

__device__ __forceinline__ XcdBarrier xcd_barrier_post(unsigned* bar, volatile LAS unsigned* st) {
    XcdBarrier b; b.bar = bar; b.x = xb_xcc_id(); b.st = st;
    if (threadIdx.x == 0) (void)xb_add(&bar[XB_XCNT(b.x)], 1u);
    return b;
}
__device__ __forceinline__ void xcd_barrier_complete(unsigned* bar, unsigned x, unsigned& nloc, unsigned& nx) {
    const unsigned G = gridDim.x * gridDim.y * gridDim.z;
    unsigned sum, cnt, mine, sp = 0u;
    for (;;) {
        sum = 0u; cnt = 0u; mine = 0u;
#pragma unroll
        for (unsigned j = 0; j < 16; ++j) { const unsigned c = xb_ld(&bar[XB_XCNT(j)]); sum += c; cnt += (c > 0u) ? 1u : 0u; mine = (j == x) ? c : mine; }
        if (sum == G) break;
        __builtin_amdgcn_s_sleep(1);
        if ((++sp & 255u) == 0u) { if (xb_ld(&bar[XB_TMO])) break; if (sp > XB_SPIN_CAP) { atomicAdd(&bar[XB_TMO], 1u); break; } }
    }
    nloc = mine > 0u ? mine : 1u; nx = cnt > 0u ? cnt : 1u;
}

__device__ __forceinline__ void xcd_barrier(const XcdBarrier& b) {
    asm volatile("s_waitcnt vmcnt(0)" ::: "memory");
    __syncthreads();
    if (threadIdx.x == 0) {
        unsigned* bar = b.bar;
        __builtin_amdgcn_s_waitcnt(0);
        unsigned nloc = b.st[0], nx = b.st[1];
        if (nloc == 0u) { xcd_barrier_complete(bar, b.x, nloc, nx); b.st[0] = nloc; b.st[1] = nx; }
        const unsigned old = xb_add(&bar[XB_XSUB(b.x)], 1u);
        const unsigned gen = old / nloc;
        if (old + 1u == (gen + 1u) * nloc) {
            __builtin_amdgcn_fence(__ATOMIC_RELEASE, "agent");
            asm volatile("s_waitcnt vmcnt(0)" ::: "memory");
            const unsigned og = xb_add(&bar[XB_TOP], 1u);
            const unsigned tg = og / nx;
            if (og + 1u == (tg + 1u) * nx) xb_add(&bar[XB_TOPGEN], 1u);
            else XB_SPIN(xb_ld(&bar[XB_TOPGEN]) == tg, bar);
            __builtin_amdgcn_fence(__ATOMIC_ACQUIRE, "agent");
            xb_add(&bar[XB_XGEN(b.x)], 1u);
            asm volatile("s_waitcnt vmcnt(0)" ::: "memory");
        } else {
            XB_SPIN(xb_ld(&bar[XB_XGEN(b.x)]) == gen, bar);
            __builtin_amdgcn_fence(__ATOMIC_ACQUIRE, "agent");
            asm volatile("s_waitcnt vmcnt(0)" ::: "memory");
        }
    }
    __syncthreads();
}
namespace mk {
constexpr int NWAVES = 8, NTHREADS = 512;
constexpr int RING_OFF = 0, RING_BYTES = 159744;
constexpr int LDSCTL_OFF = RING_BYTES, MISC_OFF = LDSCTL_OFF + 320;
constexpr int LDS_BYTES = 163840;
constexpr int CW_TMO = 0, CW_BAR = 4096;

typedef unsigned v4u __attribute__((ext_vector_type(4)));
typedef unsigned v2u __attribute__((ext_vector_type(2)));
typedef float f32x4 __attribute__((ext_vector_type(4)));
#define LDS_WAIT() asm volatile("s_waitcnt lgkmcnt(0)" ::: "memory")
#define VM_WAIT() asm volatile("s_waitcnt vmcnt(0)" ::: "memory")
#define WG_BAR() do { asm volatile("s_waitcnt lgkmcnt(0)" ::: "memory"); __builtin_amdgcn_s_barrier(); asm volatile("" ::: "memory"); } while (0)
__device__ __forceinline__ float fexp(float x) { return __builtin_amdgcn_exp2f(x * 1.4426950408889634f); }
__device__ __forceinline__ float fsigmoid(float x) { return __builtin_amdgcn_rcpf(1.0f + __builtin_amdgcn_exp2f(x * -1.4426950408889634f)); }
typedef __bf16 bf16x2_t __attribute__((ext_vector_type(2)));
typedef float f32x2_t __attribute__((ext_vector_type(2)));
__device__ __forceinline__ unsigned pk2(float lo, float hi) { const f32x2_t v = {lo, hi}; const bf16x2_t b = __builtin_convertvector(v, bf16x2_t); return __builtin_bit_cast(unsigned, b); }
__device__ __forceinline__ bf16_t f2bf_hw(float f) { return (bf16_t)(pk2(f, 0.f) & 0xffffu); }
__device__ __forceinline__ float wave_sum(float v) {
#pragma unroll
    for (int o = 1; o < 64; o <<= 1) v += __shfl_xor(v, o);
    return v;
}

struct Args {
    const float* in[25]; float* out; unsigned char* ws; int ph_lo, ph_hi;
};

struct Frame {
    LAS unsigned char* lds; volatile LAS unsigned* MISC;
    int tid, lane, wave, vcu, G;
};

__device__ __forceinline__ void p0_mod_pe(Frame& F, const float* c, const float* c_ctx, const float* ada_w, const float* ada_b, float* mod, float* pe) {
    LAS float* sc = (LAS float*)F.lds;
    LAS float* red = (LAS float*)(F.lds + 17 * 1024 * 4);
    for (int i = F.tid; i < 17 * 1024; i += NTHREADS) { const int r = i >> 10, k = i & 1023; const float v = r < 16 ? c[r * 1024 + k] : c_ctx[k]; sc[i] = siluf_(v); }
    __syncthreads();
    for (int cg = blockIdx.x; cg < 256; cg += F.G) {
        const int col0 = cg * 24;
        if (F.tid < 504) {
            const int col = F.tid % 24, kg = F.tid / 24;
            float acc[17];
#pragma unroll
            for (int r = 0; r < 17; ++r) acc[r] = 0.f;
#pragma unroll 7
            for (int k = kg; k < 1024; k += 21) { const float w = ada_w[(size_t)k * 6144 + col0 + col];
#pragma unroll
                for (int r = 0; r < 17; ++r) acc[r] += sc[r * 1024 + k] * w; }
#pragma unroll
            for (int r = 0; r < 17; ++r) red[(kg * 17 + r) * 24 + col] = acc[r];
        }
        __syncthreads();
        if (F.tid < 17 * 24) { const int r = F.tid / 24, col = F.tid % 24; float s = ada_b[col0 + col];
            for (int kg = 0; kg < 21; ++kg) s += red[(kg * 17 + r) * 24 + col];
            mod[r * 6144 + col0 + col] = s; }
        __syncthreads();
    }
    for (int p = blockIdx.x; p < 96; p += F.G) if (F.tid < 256) {
        const int i = F.tid; const double pos = p < 32 ? p : p - 32; const double omega = pow(10000.0, -(double)i / 256.0);
        pe[p * 512 + i] = (float)sin(pos * omega); pe[p * 512 + 256 + i] = (float)cos(pos * omega); }
}

template <bool HMAP>
__device__ __forceinline__ void p1_transpose_item(const float* W, int K, int N, bf16_t* WT, LAS float* scr, int item, int lane) {
    const int nblk = N / 32, kb = item / nblk, nb = item % nblk, k0 = 64 * kb, n0 = 32 * nb;
#pragma unroll 8
    for (int i = 0; i < 32; ++i) { const int kk = 2 * i + (lane >> 5); scr[kk * 33 + (lane & 31)] = W[(size_t)(k0 + kk) * N + n0 + (lane & 31)]; }
    LDS_WAIT(); asm volatile("" ::: "memory");
    const int cch = lane & 7; const int r0 = HMAP ? hmap(n0) : n0;
#pragma unroll
    for (int j = 0; j < 4; ++j) { const int n = (lane >> 3) + 8 * j; const LAS float* s = scr + (8 * cch) * 33 + n;
        v4u o; o.x = pk2(s[0 * 33], s[1 * 33]); o.y = pk2(s[2 * 33], s[3 * 33]); o.z = pk2(s[4 * 33], s[5 * 33]); o.w = pk2(s[6 * 33], s[7 * 33]);
        *(v4u*)(WT + (size_t)(r0 + n) * K + k0 + 8 * cch) = o; }
    LDS_WAIT(); asm volatile("" ::: "memory");
}
__device__ __forceinline__ void p1_fold_item(Frame& F, const float* w_q, const float* keys, bf16_t* WsT, int item) {
    LAS bf16_t* keysB = (LAS bf16_t*)F.lds;
    LAS bf16_t* wqB = (LAS bf16_t*)(F.lds + 128 * 136 * 2);
    const int hp = item >> 4, k0 = (item & 15) * 64;
    __syncthreads();
    for (int i = 0; i < 8; ++i) { const int idx = i * 512 + F.tid; const int key = idx >> 5, d4 = (idx & 31) * 4; const f32x4 v = *(const f32x4*)(keys + ((size_t)hp * 128 + key) * 128 + d4);
        v2u w; w.x = pk2(v.x, v.y); w.y = pk2(v.z, v.w); *(LAS v2u*)(keysB + key * 136 + d4) = w; }
    for (int i = 0; i < 4; ++i) { const int idx = i * 512 + F.tid; const int kk = idx >> 5, d4 = (idx & 31) * 4; const f32x4 v = *(const f32x4*)(w_q + (size_t)(k0 + kk) * 2048 + hp * 128 + d4);
        v2u w; w.x = pk2(v.x, v.y); w.y = pk2(v.z, v.w); *(LAS v2u*)(wqB + kk * 136 + d4) = w; }
    __syncthreads();
    const int fr = F.lane & 15, fq = F.lane >> 4, kt = F.wave;
    pg8::f32x4 acc[4];
#pragma unroll
    for (int m = 0; m < 4; ++m) acc[m] = (pg8::f32x4){0.f, 0.f, 0.f, 0.f};
#pragma unroll
    for (int ks = 0; ks < 4; ++ks) { const pg8::bf16x8 bfr = *(const LAS pg8::bf16x8*)(keysB + (16 * kt + fr) * 136 + 32 * ks + 8 * fq);
#pragma unroll
        for (int m = 0; m < 4; ++m) { const pg8::bf16x8 afr = *(const LAS pg8::bf16x8*)(wqB + (16 * m + fr) * 136 + 32 * ks + 8 * fq); acc[m] = __builtin_amdgcn_mfma_f32_16x16x32_bf16(afr, bfr, acc[m], 0, 0, 0); } }
    bf16_t* dst = WsT + (size_t)(hp * 128 + 16 * kt + fr) * 1024 + k0 + 4 * fq;
#pragma unroll
    for (int m = 0; m < 4; ++m) { v2u w; w.x = pk2(acc[m][0], acc[m][1]); w.y = pk2(acc[m][2], acc[m][3]); *(v2u*)(dst + 16 * m) = w; }
}
__device__ __forceinline__ void p1_xa_row(Frame& F, int row, const float* x, const float* ctx, const float* g1, const float* mod, const float* pe, bf16_t* xa) {
    f32x4 v[4]; int b;
    if (row < NL) { b = row >> 11; const int t = row & 2047; const f32x4* xr = (const f32x4*)(x + (size_t)row * D) + F.lane;
        const f32x4* p0 = (const f32x4*)(pe + (t >> 6) * 512) + F.lane; const f32x4* p1 = (const f32x4*)(pe + (32 + (t & 63)) * 512) + F.lane;
        v[0] = xr[0] + p0[0]; v[1] = xr[64] + p0[64]; v[2] = xr[128] + p1[0]; v[3] = xr[192] + p1[64];
    } else { b = 16; const f32x4* xr = (const f32x4*)(ctx + (size_t)(row - NL) * D) + F.lane;
#pragma unroll
        for (int j = 0; j < 4; ++j) v[j] = xr[64 * j]; }
    float s = 0.f;
#pragma unroll
    for (int j = 0; j < 4; ++j) s += (v[j].x * v[j].x + v[j].y * v[j].y) + (v[j].z * v[j].z + v[j].w * v[j].w);
    const float rs = rsqrtf(wave_sum(s) * (1.0f / D) + 1e-6f);
    const f32x4* gp = (const f32x4*)g1 + F.lane; const f32x4* shp = (const f32x4*)(mod + b * 6144) + F.lane; const f32x4* scp = (const f32x4*)(mod + b * 6144 + 1024) + F.lane;
    v2u* o8 = (v2u*)(xa + (size_t)row * D) + F.lane;
#pragma unroll
    for (int j = 0; j < 4; ++j) { const f32x4 g = gp[64 * j], sh = shp[64 * j], sc = scp[64 * j];
        const f32x4 o = v[j] * rs * g * (sc + 1.0f) + sh;
        v2u w; w.x = pk2(o.x, o.y); w.y = pk2(o.z, o.w); o8[64 * j] = w; }
}
__device__ __forceinline__ void p1_prologue(Frame& F, const Args& a) {
    const float* x = a.in[0]; const float* ctx = a.in[2]; const float* g1 = a.in[6]; const float* w_in = a.in[7]; const float* w_out = a.in[18];
    const float* w_q = a.in[20]; const float* keys = a.in[21]; const float* tab_u = a.in[22]; const float* tab_v = a.in[23];
    unsigned char* ws = a.ws;
    const float* mod = (const float*)(ws + OFF_MOD); const float* pe = (const float*)(ws + OFF_PE);
    bf16_t* xa = (bf16_t*)(ws + OFF_XA); bf16_t* WinT = (bf16_t*)(ws + OFF_WINT); bf16_t* WoutT = (bf16_t*)(ws + OFF_WOUTT); bf16_t* WsT = (bf16_t*)(ws + OFF_WST);
    bf16_t* tabU = (bf16_t*)(ws + OFF_TABU); bf16_t* tabV = (bf16_t*)(ws + OFF_TABV);
    for (int it = blockIdx.x; it < 256; it += F.G) p1_fold_item(F, w_q, keys, WsT, it);
    __syncthreads();
    LAS float* scr = (LAS float*)(F.lds + RING_OFF + F.wave * 16384);
    const int gw = F.vcu * NWAVES + F.wave, NGW = F.G * NWAVES;
    constexpr int I_IN = (D / 64) * (INC / 32), I_OUT = (D / 64) * (D / 32), I_PAD = 224;
    for (int it = gw; it < I_IN + I_OUT + I_PAD; it += NGW) {
        int r = it;
        if (r < I_IN) { p1_transpose_item<true>(w_in, D, INC, WinT, scr, r, F.lane); continue; } r -= I_IN;
        if (r < I_OUT) { p1_transpose_item<false>(w_out, D, D, WoutT, scr, r, F.lane); continue; } r -= I_OUT;
        { v4u z; z.x = 0; z.y = 0; z.z = 0; z.w = 0; v4u* dst = (v4u*)(WinT + (size_t)(HC_LR + 32 + r) * D) + F.lane; dst[0] = z; dst[64] = z; }
    }
    { const int r0 = gw * 16, b = r0 >> 11, t0 = r0 & 2047; const int l = F.lane;
      f32x4 cs[4], sh[4], p0[2];
#pragma unroll
      for (int j = 0; j < 4; ++j) { cs[j] = ((const f32x4*)g1)[l + 64 * j] * (((const f32x4*)(mod + b * 6144 + 1024))[l + 64 * j] + 1.0f); sh[j] = ((const f32x4*)(mod + b * 6144))[l + 64 * j]; }
      p0[0] = ((const f32x4*)(pe + (t0 >> 6) * 512))[l]; p0[1] = ((const f32x4*)(pe + (t0 >> 6) * 512))[l + 64];
      f32x4 va[4], vb[4];
      { const f32x4* xr = (const f32x4*)(x + (size_t)r0 * D) + l;
#pragma unroll
        for (int j = 0; j < 4; ++j) va[j] = xr[64 * j]; }
#pragma unroll 1
      for (int i = 0; i < 16; i += 2) {
#pragma unroll
          for (int hh = 0; hh < 2; ++hh) {
              const int row = r0 + i + hh, t = t0 + i + hh;
              const f32x4 q0 = ((const f32x4*)(pe + (32 + (t & 63)) * 512))[l], q1 = ((const f32x4*)(pe + (32 + (t & 63)) * 512))[l + 64];
              { const int nr = row + 1 < r0 + 16 ? row + 1 : row; const f32x4* xr = (const f32x4*)(x + (size_t)nr * D) + l;
                if (hh == 0) {
#pragma unroll
                    for (int j = 0; j < 4; ++j) vb[j] = xr[64 * j]; }
                else {
#pragma unroll
                    for (int j = 0; j < 4; ++j) va[j] = xr[64 * j]; } }
              f32x4 v[4];
              if (hh == 0) { v[0] = va[0] + p0[0]; v[1] = va[1] + p0[1]; v[2] = va[2] + q0; v[3] = va[3] + q1; } else { v[0] = vb[0] + p0[0]; v[1] = vb[1] + p0[1]; v[2] = vb[2] + q0; v[3] = vb[3] + q1; }
              float ssq = 0.f;
#pragma unroll
              for (int j = 0; j < 4; ++j) ssq += (v[j].x * v[j].x + v[j].y * v[j].y) + (v[j].z * v[j].z + v[j].w * v[j].w);
              const float rs = rsqrtf(wave_sum(ssq) * (1.0f / D) + 1e-6f);
              v2u* o8 = (v2u*)(xa + (size_t)row * D) + l;
#pragma unroll
              for (int j = 0; j < 4; ++j) { const f32x4 o = v[j] * rs * cs[j] + sh[j]; v2u w; w.x = pk2(o.x, o.y); w.y = pk2(o.z, o.w); o8[64 * j] = w; }
          }
      }
    }
    for (int row = NL + gw; row < NTOK; row += NGW) p1_xa_row(F, row, x, ctx, g1, mod, pe, xa);
    { const int l5 = F.lane & 31; f32x4 qn[8];
      { const int r = 2 * gw + (F.lane >> 5); const float* srow = (r >= 16384 ? tab_v + (size_t)(r - 16384) * 1024 : tab_u + (size_t)r * 1024) + 32 * l5;
#pragma unroll
        for (int i = 0; i < 8; ++i) qn[i] = ((const f32x4*)srow)[i]; }
#pragma unroll 1
      for (int rp = gw; rp < 16384; rp += NGW) {
        const int r = 2 * rp + (F.lane >> 5); const bool second = r >= 16384; const int row = second ? r - 16384 : r;
        f32x4 q[8];
#pragma unroll
        for (int i = 0; i < 8; ++i) q[i] = qn[i];
        { const int rpn = rp + NGW < 16384 ? rp + NGW : rp; const int rn = 2 * rpn + (F.lane >> 5); const float* srow = (rn >= 16384 ? tab_v + (size_t)(rn - 16384) * 1024 : tab_u + (size_t)rn * 1024) + 32 * l5;
#pragma unroll
          for (int i = 0; i < 8; ++i) qn[i] = ((const f32x4*)srow)[i]; }
        float m = 0.f;
#pragma unroll
        for (int i = 0; i < 8; ++i) m = fmaxf(m, fmaxf(fmaxf(fabsf(q[i].x), fabsf(q[i].y)), fmaxf(fabsf(q[i].z), fabsf(q[i].w))));
#pragma unroll
        for (int o = 1; o < 32; o <<= 1) m = fmaxf(m, __shfl_xor(m, o));
        float sc = 1.f;
        if (m > 0.f) { const int ex = (int)floorf(log2f(7.5f / m)); sc = ldexpf(1.0f, ex); if (m * sc > 7.5f) sc *= 0.5f; }
        unsigned w[6] = {0u, 0u, 0u, 0u, 0u, 0u};
#pragma unroll
        for (int j = 0; j < 32; ++j) { const float x = q[j >> 2][j & 3]; const float aq = fabsf(x) * sc;
            const float c = aq < 2.0f ? rintf(aq * 8.0f) : (aq < 4.0f ? 8.0f + rintf(aq * 4.0f) : fminf(16.0f + rintf(aq * 2.0f), 31.0f));
            const unsigned code = (unsigned)c | (x < 0.f ? 32u : 0u);
            const int pos = 6 * j, wi = pos >> 5, shb = pos & 31;
            w[wi] |= code << shb; if (shb > 26) w[wi + 1] |= code >> (32 - shb); }
        unsigned char* dst = (unsigned char*)(second ? tabV : tabU) + (size_t)(l5 >> 4) * 6291456 + (size_t)row * 384 + 24 * (l5 & 15);
        *(v2u*)dst = (v2u){w[0], w[1]}; *(v2u*)(dst + 8) = (v2u){w[2], w[3]}; *(v2u*)(dst + 16) = (v2u){w[4], w[5]};
        if (l5 == 0) ((float*)(ws + OFF_TSC))[r] = 1.0f / sc;
      }
    }
}

struct Sched1 {
    int G, c;
    __device__ bool next(int i, pg8::Unit& u) const {
        const int L = i * G + c; constexpr int NLAT = 128 * 11, NALL = NLAT + 16 * 6;
        if (L >= NALL) return false;
        if (L < NLAT) { constexpr int nM = 128, nN = 11, nwg = NLAT, q = nwg / 8;
            int wgid = (L % 8) * q + L / 8;
            const int nig = 4 * nN, gid = wgid / nig, fm = gid * 4; (void)nM;
            u.pm = fm + ((wgid % nig) % 4); u.pn = (wgid % nig) / 4;
        } else { const int r = L - NLAT; u.pm = 128 + r / 6; u.pn = r % 6; }
        return true;
    }
    __device__ __forceinline__ void a_ready(const pg8::Unit&) const {}
    __device__ __forceinline__ void done(const pg8::Unit&) const {}
};

struct StaticOrderW4 {
    int nM, nN, nwg, G, c;
    __device__ void init(int M, int N, int G_, int c_) { nM = M / pg8::BM; nN = N / pg8::BM; nwg = nM * nN; G = G_; c = c_; }
    __device__ bool next(int i, pg8::Unit& u) const {
        const long L = (long)i * G + c; if (L >= nwg) return false;
        int wgid = (int)L; { const int q = nwg / pg8::NXCD, r = nwg % pg8::NXCD, xcd = wgid % pg8::NXCD, off = wgid / pg8::NXCD; wgid = (xcd < r ? xcd * (q + 1) : r * (q + 1) + (xcd - r) * q) + off; }
        constexpr int W = 4; const int nig = W * nN, gid = wgid / nig, fm = gid * W, gsz = (nM - fm) < W ? (nM - fm) : W;
        u.pm = fm + ((wgid % nig) % gsz); u.pn = (wgid % nig) / gsz; return true;
    }
    __device__ __forceinline__ void a_ready(const pg8::Unit&) const {}
    __device__ __forceinline__ void done(const pg8::Unit&) const {}
};

struct EpiX1 {
    static constexpr bool PERM = true, AFTER_DRAIN = false;
    const float* x; const float* pe; const float* mod; bf16_t* out;
    __device__ __forceinline__ void ldx(int st, const pg8::Unit& u, int wr, int wc, int fr, int fq, pg8::f32x4 (&X)[2]) const {
        const int ai = st >> 3, m = (st >> 1) & 3, bj = st & 1;
        const int r = u.pm * 256 + ai * 128 + wr * 64 + m * 16 + fr, c = u.pn * 256 + wc * 32 + 8 * fq + bj * 128;
        X[0] = *(const pg8::f32x4*)(x + (size_t)r * D + c); X[1] = *(const pg8::f32x4*)(x + (size_t)r * D + c + 4);
    }
    __device__ __forceinline__ void ldp(int st, const pg8::Unit& u, int wr, int wc, int fr, int fq, pg8::f32x4 (&P)[2]) const {
        const int ai = st >> 3, m = (st >> 1) & 3, bj = st & 1;
        const int r = u.pm * 256 + ai * 128 + wr * 64 + m * 16 + fr, t = r & 2047, c = u.pn * 256 + wc * 32 + 8 * fq + bj * 128;
        const float* pp = c < 512 ? pe + (t >> 6) * 512 + c : pe + (32 + (t & 63)) * 512 + (c - 512);
        P[0] = *(const pg8::f32x4*)pp; P[1] = *(const pg8::f32x4*)(pp + 4);
    }
    __device__ __forceinline__ void operator()(const pg8::f32x4 (&acc)[2][2][4][2], const pg8::Unit& u, int wr, int wc, int fr, int fq) const {
        const int col0 = u.pn * 256 + wc * 32 + 8 * fq; const int b = (u.pm * 256) >> 11;
        pg8::f32x4 G[2][2];
#pragma unroll
        for (int bj = 0; bj < 2; ++bj)
#pragma unroll
            for (int n = 0; n < 2; ++n) G[bj][n] = *(const pg8::f32x4*)(mod + b * 6144 + 2048 + col0 + bj * 128 + 4 * n);
        pg8::f32x4 X[4][2], P[2][2];
        ldx(0, u, wr, wc, fr, fq, X[0]); ldp(0, u, wr, wc, fr, fq, P[0]); ldx(1, u, wr, wc, fr, fq, X[1]); ldx(2, u, wr, wc, fr, fq, X[2]);
#pragma unroll
        for (int st = 0; st < 16; ++st) {
            if (st + 1 < 16) ldp(st + 1, u, wr, wc, fr, fq, P[(st + 1) & 1]);
            if (st + 3 < 16) ldx(st + 3, u, wr, wc, fr, fq, X[(st + 3) & 3]);
            const int ai = st >> 3, m = (st >> 1) & 3, bj = st & 1;
            const int r = u.pm * 256 + ai * 128 + wr * 64 + m * 16 + fr;
            const pg8::f32x4 o0 = X[st & 3][0] + P[st & 1][0] + G[bj][0] * acc[ai][bj][m][0], o1 = X[st & 3][1] + P[st & 1][1] + G[bj][1] * acc[ai][bj][m][1];
            v4u w; w.x = pk2(o0[0], o0[1]); w.y = pk2(o0[2], o0[3]); w.z = pk2(o1[0], o1[1]); w.w = pk2(o1[2], o1[3]);
            *(v4u*)(out + (size_t)r * D + col0 + bj * 128) = w;
            __builtin_amdgcn_sched_barrier(0); }
    }
};
typedef _Float16 h16x2_t __attribute__((ext_vector_type(2)));
__device__ __forceinline__ unsigned pkh2(float lo, float hi) { h16x2_t h; h.x = (_Float16)lo; h.y = (_Float16)hi; return __builtin_bit_cast(unsigned, h); }
struct EpiS {
    static constexpr bool PERM = true, AFTER_DRAIN = false;
    unsigned short* s;
    __device__ __forceinline__ void operator()(const pg8::f32x4 (&acc)[2][2][4][2], const pg8::Unit& u, int wr, int wc, int fr, int fq) const {
        const int col0 = u.pn * 256 + wc * 32 + 8 * fq;
#pragma unroll
        for (int ai = 0; ai < 2; ++ai)
#pragma unroll
            for (int m = 0; m < 4; ++m) { const int r = u.pm * 256 + ai * 128 + wr * 64 + m * 16 + fr; unsigned short* rowp = s + (size_t)r * 2048 + col0;
#pragma unroll
                for (int bj = 0; bj < 2; ++bj) { const pg8::f32x4 v0 = acc[ai][bj][m][0], v1 = acc[ai][bj][m][1];
                    v4u w; w.x = pkh2(v0[0], v0[1]); w.y = pkh2(v0[2], v0[3]); w.z = pkh2(v1[0], v1[1]); w.w = pkh2(v1[2], v1[3]); *(v4u*)(rowp + bj * 128) = w; } }
    }
};

__device__ __forceinline__ void unpack8(const v4u w, float (&f)[8]) {
    f[0] = __uint_as_float(w.x << 16); f[1] = __uint_as_float(w.x & 0xffff0000u); f[2] = __uint_as_float(w.y << 16); f[3] = __uint_as_float(w.y & 0xffff0000u);
    f[4] = __uint_as_float(w.z << 16); f[5] = __uint_as_float(w.z & 0xffff0000u); f[6] = __uint_as_float(w.w << 16); f[7] = __uint_as_float(w.w & 0xffff0000u);
}
__device__ __forceinline__ void p4_merge(Frame& F, const bf16_t* h, const bf16_t* y, const bf16_t* o, const float* gng, bf16_t* a2) {
    const int gw0 = F.vcu * NWAVES + F.wave, gw = (gw0 >> 8) * 4096 + (gw0 & 255), NGW = 256, l = F.lane;
    float gn[8];
#pragma unroll
    for (int e = 0; e < 8; ++e) gn[e] = gng[(8 * l + e) & 127];
    for (int rk = 0; rk < 16; ++rk) { const int row = gw + rk * NGW;
        const bf16_t* hr = h + (size_t)row * HC;
        float yf[8], yb[8], gt[8], of[8], ob[8], rr[8];
        unpack8(*(const v4u*)(y + (size_t)row * 512 + 8 * l), yf); unpack8(*(const v4u*)(y + ((size_t)NL + row) * 512 + 8 * l), yb);
        unpack8(*(const v4u*)(hr + HC_RG + 8 * l), gt);
        unpack8(*(const v4u*)(o + (size_t)row * 512 + 8 * l), of); unpack8(*(const v4u*)(o + ((size_t)NL + row) * 512 + 8 * l), ob);
        unpack8(*(const v4u*)(hr + HC_R + 8 * l), rr);
        float a[8], ss = 0.f;
#pragma unroll
        for (int e = 0; e < 8; e += 2) { pg8::f32x2 g2 = pg8::gelu_pk((pg8::f32x2){gt[e], gt[e + 1]}); a[e] = (yf[e] + yb[e]) * g2.x; a[e + 1] = (yf[e + 1] + yb[e + 1]) * g2.y; }
        v4u w; w.x = pk2(a[0], a[1]); w.y = pk2(a[2], a[3]); w.z = pk2(a[4], a[5]); w.w = pk2(a[6], a[7]);
        *(v4u*)(a2 + (size_t)row * D + 8 * l) = w;
#pragma unroll
        for (int e = 0; e < 8; ++e) { of[e] += ob[e]; ss += of[e] * of[e]; }
        ss += __shfl_xor(ss, 1); ss += __shfl_xor(ss, 2); ss += __shfl_xor(ss, 4); ss += __shfl_xor(ss, 8);
        const float rs = rsqrtf(ss * (1.0f / 128.0f) + 1e-6f);
#pragma unroll
        for (int e = 0; e < 8; ++e) a[e] = of[e] * rs * gn[e] * siluf_(rr[e]);
        w.x = pk2(a[0], a[1]); w.y = pk2(a[2], a[3]); w.z = pk2(a[4], a[5]); w.w = pk2(a[6], a[7]);
        *(v4u*)(a2 + (size_t)row * D + 512 + 8 * l) = w;
    }
}
__device__ __forceinline__ void p6_norm2(Frame& F, const bf16_t* x1, const float* g2, const float* mod, bf16_t* u) {
    const int gw0 = F.vcu * NWAVES + F.wave, gw = (gw0 >> 8) * 4096 + (gw0 & 255), NGW = 256;
    for (int rk = 0; rk < 16; ++rk) { const int row = gw + rk * NGW;
        const int b = row >> 11; const v4u* xr = (const v4u*)(x1 + (size_t)row * D) + F.lane; float v[2][8]; float s2 = 0.f;
#pragma unroll
        for (int j = 0; j < 2; ++j) { const v4u w = xr[64 * j]; const unsigned ww[4] = {w.x, w.y, w.z, w.w};
#pragma unroll
            for (int e = 0; e < 4; ++e) { v[j][2 * e] = __uint_as_float(ww[e] << 16); v[j][2 * e + 1] = __uint_as_float(ww[e] & 0xffff0000u); s2 += v[j][2 * e] * v[j][2 * e] + v[j][2 * e + 1] * v[j][2 * e + 1]; } }
        const float rs = rsqrtf(wave_sum(s2) * (1.0f / D) + 1e-6f);
        const float* gp = g2 + 8 * F.lane; const float* shp = mod + b * 6144 + 3072 + 8 * F.lane; const float* scp = mod + b * 6144 + 4096 + 8 * F.lane;
        v4u* o8 = (v4u*)(u + (size_t)row * D) + F.lane;
#pragma unroll
        for (int j = 0; j < 2; ++j) { float o[8];
#pragma unroll
            for (int h2 = 0; h2 < 2; ++h2) { const f32x4 g = *(const f32x4*)(gp + 512 * j + 4 * h2), sh = *(const f32x4*)(shp + 512 * j + 4 * h2), sc = *(const f32x4*)(scp + 512 * j + 4 * h2);
#pragma unroll
                for (int e = 0; e < 4; ++e) o[4 * h2 + e] = v[j][4 * h2 + e] * rs * g[e] * (sc[e] + 1.0f) + sh[e]; }
            v4u w; w.x = pk2(o[0], o[1]); w.y = pk2(o[2], o[3]); w.z = pk2(o[4], o[5]); w.w = pk2(o[6], o[7]); o8[64 * j] = w; }
    }
}

__device__ __forceinline__ float dot2bf(unsigned a, unsigned b, float c) { return __builtin_amdgcn_fdot2_f32_bf16(__builtin_bit_cast(bf16x2_t, a), __builtin_bit_cast(bf16x2_t, b), c, false); }
template <int CTRL> __device__ __forceinline__ unsigned dpp_u(unsigned x) { return (unsigned)__builtin_amdgcn_update_dpp((int)x, (int)x, CTRL, 0xF, 0xF, false); }
template <int CTRL> __device__ __forceinline__ float dpp_f(float x) { return __uint_as_float(dpp_u<CTRL>(__float_as_uint(x))); }
constexpr int DPP_X1 = 0xB1, DPP_X2 = 0x4E, DPP_HM = 0x141;
__device__ __forceinline__ unsigned ord_key(float v) { const unsigned b = __float_as_uint(v); return b ^ ((unsigned)((int)b >> 31) | 0x80000000u); }
__device__ __forceinline__ unsigned umax3(unsigned a, unsigned b, unsigned c) { return max(max(a, b), c); }
constexpr int P8_WAVE_LDS = 18432, P8_TBL_OFF = 8 * P8_WAVE_LDS;

__device__ __forceinline__ float key_score(unsigned k) {
    const unsigned o = k >> 16; const unsigned hb = (o & 0x8000u) ? (o ^ 0x8000u) : (~o & 0xFFFFu);
    const unsigned short hs = (unsigned short)hb; return (float)__builtin_bit_cast(_Float16, hs);
}
struct P8Pend { unsigned e0, e1; float w0, w1, su0, su1, sv0, sv1; };
template <int N> __device__ __forceinline__ void bitonic_sort_desc(unsigned (&a)[N]) {
#pragma unroll
    for (int k = 2; k <= N; k <<= 1)
#pragma unroll
        for (int j = k >> 1; j > 0; j >>= 1)
#pragma unroll
            for (int i = 0; i < N; ++i) { const int l = i ^ j; if (l > i) { const unsigned hi = max(a[i], a[l]), lo = min(a[i], a[l]); if ((i & k) == 0) { a[i] = hi; a[l] = lo; } else { a[i] = lo; a[l] = hi; } } }
}
template <int N> __device__ __forceinline__ void oem_sort_desc(unsigned (&a)[N]) {
#pragma unroll
    for (int p = 1; p < N; p <<= 1)
#pragma unroll
        for (int k = p; k >= 1; k >>= 1)
#pragma unroll
            for (int j = k % p; j <= N - 1 - k; j += 2 * k)
#pragma unroll
                for (int i = 0; i < k; ++i) { const int x = i + j, y = i + j + k;
                    if (y < N && (x / (2 * p)) == (y / (2 * p))) { const unsigned hi = max(a[x], a[y]), lo = min(a[x], a[y]); a[x] = hi; a[y] = lo; } }
}
template <int N> __device__ __forceinline__ void bitonic_merge_desc(unsigned (&a)[N]) {
#pragma unroll
    for (int j = N >> 1; j > 0; j >>= 1)
#pragma unroll
        for (int i = 0; i < N; ++i) { const int l = i ^ j; if (l > i) { const unsigned hi = max(a[i], a[l]), lo = min(a[i], a[l]); a[i] = hi; a[l] = lo; } }
}
template <int CTRL> __device__ __forceinline__ void top16_exchange(unsigned (&t)[16]) {
    unsigned p[16];
#pragma unroll
    for (int i = 0; i < 16; ++i) p[i] = dpp_u<CTRL>(t[15 - i]);
#pragma unroll
    for (int i = 0; i < 16; ++i) t[i] = max(t[i], p[i]);
    bitonic_merge_desc<16>(t);
}
__device__ __forceinline__ void p8_route_token(const v4u (&sh)[4], const float* tsc, LAS unsigned char* wl, const LAS unsigned* tbl, int lane, P8Pend& R) {
    LAS float* l1v = (LAS float*)wl; LAS unsigned* l1i = (LAS unsigned*)(wl + 1024);
    const int g = lane >> 2, q = lane & 3;
    unsigned ka[16], kb[16];
    typedef short s16x2_t __attribute__((ext_vector_type(2)));
#pragma unroll
    for (int i = 0; i < 4; ++i) {
#pragma unroll
        for (int w = 0; w < 4; ++w) { const unsigned dd = sh[i][w];
            const s16x2_t hv = __builtin_bit_cast(s16x2_t, dd); const s16x2_t mm = hv >> 15; const unsigned ord = dd ^ (__builtin_bit_cast(unsigned, mm) | 0x80008000u);
            const int p = 8 * i + 2 * w; const unsigned klo = (ord << 16) | (unsigned)(31 - p), khi = (ord & 0xFFFF0000u) | (unsigned)(31 - (p + 1));
            if (p < 16) { ka[p] = klo; ka[p + 1] = khi; } else { kb[p - 16] = klo; kb[p - 15] = khi; } } }
    oem_sort_desc<16>(ka); oem_sort_desc<16>(kb);
#pragma unroll
    for (int i = 0; i < 16; ++i) ka[i] = max(ka[i], kb[15 - i]);
    bitonic_merge_desc<16>(ka);
    { const unsigned hq = (unsigned)(3 - q) << 5;
#pragma unroll
      for (int i = 0; i < 16; ++i) ka[i] |= hq; }
    top16_exchange<DPP_X1>(ka); top16_exchange<DPP_X2>(ka);
    { const unsigned m0 = q == 0 ? ~0u : 0u, m1 = q == 1 ? ~0u : 0u, m2 = q == 2 ? ~0u : 0u, m3 = q == 3 ? ~0u : 0u; f32x4 vv; v4u ii;
#pragma unroll
      for (int t = 0; t < 4; ++t) { const unsigned m = (ka[t] & m0) | (ka[4 + t] & m1) | (ka[8 + t] & m2) | (ka[12 + t] & m3); vv[t] = key_score(m); ii[t] = 127u - (m & 127u); }
      *(LAS f32x4*)(l1v + g * 16 + q * 4) = vv; *(LAS v4u*)(l1i + g * 16 + q * 4) = ii; }
    LDS_WAIT(); asm volatile("" ::: "memory");
    const int hd = lane >> 3, q8 = lane & 7;
    const LAS float* v1 = l1v + (2 * hd) * 16; const LAS float* v2 = l1v + (2 * hd + 1) * 16;
    unsigned ck[8];
#pragma unroll
    for (int t = 0; t < 7; ++t) { const unsigned c = tbl[t * 8 + q8]; const bool valid = c < 256u; const unsigned cc = valid ? c : 0u;
        const float sum = v1[cc >> 4] + v2[cc & 15]; ck[t] = valid ? ((ord_key(sum) & 0xFFFFFF00u) | (255u - cc)) : 0u; }
    ck[7] = 0u;
    oem_sort_desc<8>(ck);
    unsigned t16[16];
#pragma unroll
    for (int i = 0; i < 8; ++i) { t16[i] = ck[i]; t16[8 + i] = dpp_u<DPP_X1>(ck[7 - i]); }
    bitonic_merge_desc<16>(t16);
    top16_exchange<DPP_X2>(t16); top16_exchange<DPP_HM>(t16);
    const unsigned c0 = 255u - (t16[0] & 255u); const float smax = v1[c0 >> 4] + v2[c0 & 15];
    unsigned mine2[2] = {0u, 0u};
#pragma unroll
    for (int z = 0; z < 8; ++z) { const unsigned mz = q8 == z ? ~0u : 0u; mine2[0] |= t16[2 * z] & mz; mine2[1] |= t16[2 * z + 1] & mz; }
    float p[2]; unsigned e[2];
#pragma unroll
    for (int t = 0; t < 2; ++t) { const unsigned c = 255u - (mine2[t] & 255u); const unsigned i = c >> 4, j = c & 15;
        p[t] = fexp((v1[i] + v2[j]) - smax); e[t] = l1i[(2 * hd) * 16 + i] * 128u + l1i[(2 * hd + 1) * 16 + j]; }
    float ps = p[0] + p[1];
    ps += dpp_f<DPP_X1>(ps); ps += dpp_f<DPP_X2>(ps); ps += dpp_f<DPP_HM>(ps);
    const float inv = __builtin_amdgcn_rcpf(ps);
    R.e0 = e[0]; R.e1 = e[1]; R.w0 = p[0] * inv; R.w1 = p[1] * inv;
    R.su0 = tsc[e[0]]; R.su1 = tsc[e[1]]; R.sv0 = tsc[16384 + e[0]]; R.sv1 = tsc[16384 + e[1]];
    LDS_WAIT(); asm volatile("" ::: "memory");
}
__device__ __forceinline__ void p8_route_flush(const P8Pend& R, LAS unsigned char* tok, int lane) {
    v2u ve, vw; ve.x = R.e0 | (((__float_as_uint(R.su0) >> 23) & 0xFFu) << 16); ve.y = R.e1 | (((__float_as_uint(R.su1) >> 23) & 0xFFu) << 16);
    vw.x = __float_as_uint(R.w0 * R.sv0); vw.y = __float_as_uint(R.w1 * R.sv1);
    *(LAS v2u*)((LAS unsigned*)tok + 2 * lane) = ve; *(LAS v2u*)((LAS unsigned*)(tok + 512) + 2 * lane) = vw;
}
typedef unsigned v6u_t __attribute__((ext_vector_type(6)));
typedef float v32f_t __attribute__((ext_vector_type(32)));
typedef __bf16 v32bf_t __attribute__((ext_vector_type(32)));
typedef unsigned v16u_t __attribute__((ext_vector_type(16)));
__device__ __forceinline__ v16u_t p8_cvt_bf(const v4u& ra, const v2u& rb) { v6u_t x; x[0] = ra.x; x[1] = ra.y; x[2] = ra.z; x[3] = ra.w; x[4] = rb.x; x[5] = rb.y; const v32bf_t f = __builtin_amdgcn_cvt_scalef32_pk32_bf16_fp6(x, 1.0f); return __builtin_bit_cast(v16u_t, f); }
__device__ __forceinline__ v32f_t p8_cvt(const v4u& ra, const v2u& rb) { v6u_t x; x[0] = ra.x; x[1] = ra.y; x[2] = ra.z; x[3] = ra.w; x[4] = rb.x; x[5] = rb.y; return __builtin_amdgcn_cvt_scalef32_pk32_f32_fp6(x, 1.0f); }
__device__ __forceinline__ void p8a_route(Frame& F, const float* sbuf, const float* tsc) {
    LAS unsigned* tbl = (LAS unsigned*)(F.lds + P8_TBL_OFF);
    __syncthreads();
    if (F.tid == 0) { int n = 0; for (int i = 0; i < 16; ++i) for (int j = 0; j < 16; ++j) if ((i + 1) * (j + 1) <= 16) tbl[n++] = (unsigned)(i * 16 + j); for (; n < 56; ++n) tbl[n] = 0xFFFFu; }
    __syncthreads();
    LAS unsigned char* wl = F.lds + F.wave * P8_WAVE_LDS; LAS unsigned char* rscr = wl + 16384;
    const int gw0 = F.vcu * NWAVES + F.wave, gw = (gw0 >> 8) * 4096 + (gw0 & 255), NGW = 256, g = F.lane >> 2, q = F.lane & 3;
    const unsigned short* sh16 = (const unsigned short*)sbuf;
    v4u sv[4], nv[4];
    { const v4u* p = (const v4u*)(sh16 + (size_t)gw * 2048 + g * 128 + q * 32);
#pragma unroll
      for (int i = 0; i < 4; ++i) sv[i] = p[i]; }
    P8Pend PA, PB; PB.e0 = 0u; PB.e1 = 0u; PB.w0 = 0.f; PB.w1 = 0.f; PB.su0 = 0.f; PB.su1 = 0.f; PB.sv0 = 0.f; PB.sv1 = 0.f;
    for (int it = 0; it < 8; ++it) {
        const int row = gw + 2 * it * NGW, r1 = row + NGW, r2 = it < 7 ? row + 2 * NGW : row;
        { const v4u* p = (const v4u*)(sh16 + (size_t)r1 * 2048 + g * 128 + q * 32);
#pragma unroll
          for (int i = 0; i < 4; ++i) nv[i] = p[i]; }
        p8_route_token(sv, tsc, rscr, tbl, F.lane, PA);
        p8_route_flush(PB, wl + (it > 0 ? 2 * it - 1 : 0) * 1024, F.lane);
        { const v4u* p = (const v4u*)(sh16 + (size_t)r2 * 2048 + g * 128 + q * 32);
#pragma unroll
          for (int i = 0; i < 4; ++i) sv[i] = p[i]; }
        p8_route_token(nv, tsc, rscr, tbl, F.lane, PB);
        p8_route_flush(PA, wl + (2 * it) * 1024, F.lane);
    }
    p8_route_flush(PB, wl + 15 * 1024, F.lane);
    LDS_WAIT(); asm volatile("" ::: "memory");
}
__device__ __forceinline__ void p8h_load8(v4u (&Ra)[8], v2u (&Rb)[8], const unsigned char* tabh, const LAS unsigned* sel_e, int kb, int lane) {
#pragma unroll
    for (int j = 0; j < 8; ++j) { const unsigned e = sel_e[4 * (kb * 8 + j) + (lane >> 4)] & 0xFFFFu; const unsigned char* p = tabh + (size_t)e * 384 + 24 * (lane & 15); Ra[j] = *(const v4u*)p; Rb[j] = *(const v2u*)(p + 16); }
}
__device__ __forceinline__ void p8h_dot8(v4u (&Ra)[8], v2u (&Rb)[8], const unsigned (&u)[16], int kb, LAS float* act, float* part, float pt, bool first, int lane, const LAS unsigned* sel_e,
                                         const unsigned char* ntabh, const LAS unsigned* nsel, int nkb) {
    const bool b3 = lane & 8, b2 = lane & 4;
    float p[8];
#pragma unroll
    for (int j = 0; j < 8; ++j) { const v16u_t f = p8_cvt_bf(Ra[j], Rb[j]); float a0 = 0.f, a1 = 0.f;
        { const unsigned e = nsel[4 * (nkb * 8 + j) + (lane >> 4)] & 0xFFFFu; const unsigned char* pp = ntabh + (size_t)e * 384 + 24 * (lane & 15); Ra[j] = *(const v4u*)pp; Rb[j] = *(const v2u*)(pp + 16); }
#pragma unroll
        for (int i = 0; i < 8; ++i) { const unsigned w0 = f[2 * i], w1 = f[2 * i + 1]; a0 = dot2bf(w0, u[2 * i], a0); a1 = dot2bf(w1, u[2 * i + 1], a1); }
        p[j] = a0 + a1; }
    float q4[4], q2[2];
#pragma unroll
    for (int i = 0; i < 4; ++i) { const float send = b3 ? p[i] : p[i + 4], keep = b3 ? p[i + 4] : p[i]; q4[i] = keep + __shfl_xor(send, 8); }
#pragma unroll
    for (int i = 0; i < 2; ++i) { const float send = b2 ? q4[i] : q4[i + 2], keep = b2 ? q4[i + 2] : q4[i]; q2[i] = keep + __shfl_xor(send, 4); }
#pragma unroll
    for (int i = 0; i < 2; ++i) { q2[i] += dpp_f<DPP_X1>(q2[i]); q2[i] += dpp_f<DPP_X2>(q2[i]); }
    const int j = (b3 ? 4 : 0) + (b2 ? 2 : 0) + (lane & 1), kk = 4 * (kb * 8 + j) + (lane >> 4);
    float t = (lane & 1) ? q2[1] : q2[0];
    const bool owner = (lane & 2) == 0;
    if (first) { if (owner) part[kk] = t; }
    else {
        t += pt;
        const float su = __uint_as_float((sel_e[kk] >> 16) << 23);
        const float a = pg8::gelu_pk((pg8::f32x2){t * su, 0.f}).x * act[kk];
        if (owner) act[kk] = a; }
}
__device__ __forceinline__ void p8h_acc8(v4u (&Ra)[8], v2u (&Rb)[8], f32x2_t (&y)[16], int kb, const LAS float* act, int lane, const unsigned char* ntabh, const LAS unsigned* nsel, int nkb) {
#pragma unroll
    for (int j = 0; j < 8; ++j) { const float a = act[4 * (kb * 8 + j) + (lane >> 4)]; const v32f_t f = p8_cvt(Ra[j], Rb[j]);
        { const unsigned e = nsel[4 * (nkb * 8 + j) + (lane >> 4)] & 0xFFFFu; const unsigned char* pp = ntabh + (size_t)e * 384 + 24 * (lane & 15); Ra[j] = *(const v4u*)pp; Rb[j] = *(const v2u*)(pp + 16); }
#pragma unroll
        for (int i = 0; i < 16; ++i) y[i] += (f32x2_t){f[2 * i], f[2 * i + 1]} * a; }
}
struct P8Pre { v4u u0, u1, u2, u3; float pt[4]; };
__device__ __forceinline__ void p8h_prefetch(P8Pre& P, int row, const bf16_t* ubufh, const unsigned char* sbytes, bool first, int lane) {
    const v4u* up = (const v4u*)(ubufh + (size_t)row * D + 32 * (lane & 15)); P.u0 = up[0]; P.u1 = up[1]; P.u2 = up[2]; P.u3 = up[3];
    if (!first) { const float* part = (const float*)(sbytes + (size_t)row * 4096); const int j = (lane & 8 ? 4 : 0) + (lane & 4 ? 2 : 0) + (lane & 1);
#pragma unroll
        for (int kb = 0; kb < 4; ++kb) P.pt[kb] = part[4 * (kb * 8 + j) + (lane >> 4)]; }
}
__device__ __forceinline__ void p8h_u_token(v4u (&Aa)[8], v2u (&Ab)[8], v4u (&Ba)[8], v2u (&Bb)[8], int nrow, const P8Pre& P, P8Pre& NP, const bf16_t* ubufh, const unsigned char* tabUh, LAS unsigned char* tok, unsigned char* sbytes, int row, bool first, int lane,
                                            const unsigned char* ntabh, const LAS unsigned* nsel) {
    const LAS unsigned* sel_e = (const LAS unsigned*)tok; LAS float* act = (LAS float*)(tok + 512); float* part = (float*)(sbytes + (size_t)row * 4096);
    unsigned u[16];
    u[0] = P.u0.x; u[1] = P.u0.y; u[2] = P.u0.z; u[3] = P.u0.w; u[4] = P.u1.x; u[5] = P.u1.y; u[6] = P.u1.z; u[7] = P.u1.w;
    u[8] = P.u2.x; u[9] = P.u2.y; u[10] = P.u2.z; u[11] = P.u2.w; u[12] = P.u3.x; u[13] = P.u3.y; u[14] = P.u3.z; u[15] = P.u3.w;
    p8h_prefetch(NP, nrow, ubufh, sbytes, first, lane);
    p8h_dot8(Aa, Ab, u, 0, act, part, P.pt[0], first, lane, sel_e, tabUh, sel_e, 2);
    p8h_dot8(Ba, Bb, u, 1, act, part, P.pt[1], first, lane, sel_e, tabUh, sel_e, 3);
    p8h_dot8(Aa, Ab, u, 2, act, part, P.pt[2], first, lane, sel_e, ntabh, nsel, 0);
    p8h_dot8(Ba, Bb, u, 3, act, part, P.pt[3], first, lane, sel_e, ntabh, nsel, 1);
    LDS_WAIT(); asm volatile("" ::: "memory");
}
__device__ __forceinline__ void p8h_v_token(v4u (&Aa)[8], v2u (&Ab)[8], v4u (&Ba)[8], v2u (&Bb)[8], int row, int hcol, const unsigned char* tabVh, const float* mod, const float* fg, float* outbuf, const bf16_t* x1b, LAS unsigned char* tok, LAS float* ssq, int lane,
                                            const unsigned char* ntabh, const LAS unsigned* nsel) {
    const LAS unsigned* sel_e = (const LAS unsigned*)tok; const LAS float* act = (const LAS float*)(tok + 512);
    const int b = row >> 11;
    const int eo = 32 * (lane & 15) + 16 * (lane >> 5) + 8 * ((lane >> 4) & 1);
    float* orow = outbuf + (size_t)row * D + hcol + eo; const float* mg = mod + b * 6144 + 5120 + hcol + eo; const float* fgp = fg + hcol + eo;
    f32x2_t y[16];
#pragma unroll
    for (int i = 0; i < 16; ++i) y[i] = (f32x2_t){0.f, 0.f};
    f32x4 xv[2], gv[2], lo[2];
#pragma unroll
    for (int i = 0; i < 2; ++i) gv[i] = *(const f32x4*)(mg + 4 * i);
    { const v4u lb = *(const v4u*)(x1b + (size_t)row * D + eo);
      lo[0].x = __uint_as_float(lb.x << 16); lo[0].y = __uint_as_float(lb.x & 0xffff0000u); lo[0].z = __uint_as_float(lb.y << 16); lo[0].w = __uint_as_float(lb.y & 0xffff0000u);
      lo[1].x = __uint_as_float(lb.z << 16); lo[1].y = __uint_as_float(lb.z & 0xffff0000u); lo[1].z = __uint_as_float(lb.w << 16); lo[1].w = __uint_as_float(lb.w & 0xffff0000u); }
    { const v4u xb = *(const v4u*)(x1b + (size_t)row * D + hcol + eo);
      xv[0].x = __uint_as_float(xb.x << 16); xv[0].y = __uint_as_float(xb.x & 0xffff0000u); xv[0].z = __uint_as_float(xb.y << 16); xv[0].w = __uint_as_float(xb.y & 0xffff0000u);
      xv[1].x = __uint_as_float(xb.z << 16); xv[1].y = __uint_as_float(xb.z & 0xffff0000u); xv[1].z = __uint_as_float(xb.w << 16); xv[1].w = __uint_as_float(xb.w & 0xffff0000u); }
    p8h_acc8(Aa, Ab, y, 0, act, lane, tabVh, sel_e, 2);
    p8h_acc8(Ba, Bb, y, 1, act, lane, tabVh, sel_e, 3);
    p8h_acc8(Aa, Ab, y, 2, act, lane, ntabh, nsel, 0);
    p8h_acc8(Ba, Bb, y, 3, act, lane, ntabh, nsel, 1);
    const bool hi = lane >= 32, up = lane & 16; f32x2_t ym[8], yq[4];
#pragma unroll
    for (int i = 0; i < 8; ++i) { const f32x2_t send = hi ? y[i] : y[8 + i], keep = hi ? y[8 + i] : y[i]; f32x2_t recv; recv.x = __shfl_xor(send.x, 32); recv.y = __shfl_xor(send.y, 32); ym[i] = keep + recv; }
#pragma unroll
    for (int i = 0; i < 4; ++i) { const f32x2_t send = up ? ym[i] : ym[4 + i], keep = up ? ym[4 + i] : ym[i]; f32x2_t recv; recv.x = __shfl_xor(send.x, 16); recv.y = __shfl_xor(send.y, 16); yq[i] = keep + recv; }
    f32x4 v[2]; float ss = 0.f;
#pragma unroll
    for (int i = 0; i < 2; ++i) {
        v[i].x = xv[i].x + gv[i].x * yq[2 * i].x; v[i].y = xv[i].y + gv[i].y * yq[2 * i].y; v[i].z = xv[i].z + gv[i].z * yq[2 * i + 1].x; v[i].w = xv[i].w + gv[i].w * yq[2 * i + 1].y;
        ss += (v[i].x * v[i].x + v[i].y * v[i].y) + (v[i].z * v[i].z + v[i].w * v[i].w); }
    ss = wave_sum(ss);
    if (hcol == 0) {
        if (lane == 0) *ssq = ss;
        { v4u w; w.x = pk2(v[0].x, v[0].y); w.y = pk2(v[0].z, v[0].w); w.z = pk2(v[1].x, v[1].y); w.w = pk2(v[1].z, v[1].w); *(v4u*)((bf16_t*)x1b + (size_t)row * D + eo) = w; }
    } else {
        const float rs = rsqrtf((ss + *ssq) * (1.0f / D) + 1e-6f);
#pragma unroll
        for (int i = 0; i < 2; ++i) { const f32x4 g = *(const f32x4*)(fgp + 4 * i), gl = *(const f32x4*)(fgp - hcol + 4 * i); *(f32x4*)(orow + 4 * i) = v[i] * rs * g; *(f32x4*)(orow - hcol + 4 * i) = lo[i] * rs * gl; }
    }
}
__device__ __forceinline__ void p8b_peer(Frame& F, const bf16_t* ubuf, const unsigned char* tabU, const unsigned char* tabV, const float* mod, const float* fg, float* outbuf, unsigned char* sbytes, const bf16_t* x1b) {
    LAS unsigned char* wl = F.lds + F.wave * P8_WAVE_LDS; LAS float* ssq = (LAS float*)(wl + 16384);
    const int gw0 = F.vcu * NWAVES + F.wave, gw = (gw0 >> 8) * 4096 + (gw0 & 255), NGW = 256;
    v4u Aa[8], Ba[8]; v2u Ab[8], Bb[8];
    p8h_load8(Aa, Ab, tabU, (const LAS unsigned*)wl, 0, F.lane); p8h_load8(Ba, Bb, tabU, (const LAS unsigned*)wl, 1, F.lane);
    for (int h = 0; h < 2; ++h) {
        const bf16_t* ubufh = ubuf + 512 * h; const unsigned char* tabUh = tabU + (size_t)6291456 * h; const unsigned char* tabNext = h == 0 ? tabU + 6291456 : tabV;
        P8Pre PA, PB;
        if (h) WG_BAR();
        p8h_prefetch(PA, gw, ubufh, sbytes, h == 0, F.lane);
        for (int i = 0; i < 16; i += 2) {
            const int r0 = gw + i * NGW, r1 = gw + (i + 1) * NGW, r2 = i + 2 < 16 ? gw + (i + 2) * NGW : gw;
            p8h_u_token(Aa, Ab, Ba, Bb, r1, PA, PB, ubufh, tabUh, wl + i * 1024, sbytes, r0, h == 0, F.lane, tabUh, (const LAS unsigned*)(wl + (i + 1) * 1024));
            p8h_u_token(Aa, Ab, Ba, Bb, r2, PB, PA, ubufh, tabUh, wl + (i + 1) * 1024, sbytes, r1, h == 0, F.lane, i + 2 < 16 ? tabUh : tabNext, (const LAS unsigned*)(wl + (i + 2 < 16 ? i + 2 : 0) * 1024));
        }
    }
    for (int h = 0; h < 2; ++h) { WG_BAR();
        for (int i = 0; i < 16; ++i) p8h_v_token(Aa, Ab, Ba, Bb, gw + i * NGW, 512 * h, tabV + (size_t)6291456 * h, mod, fg, outbuf, x1b, wl + i * 1024, ssq + i, F.lane,
                                                 i < 15 ? tabV + (size_t)6291456 * h : tabV + 6291456, (const LAS unsigned*)(wl + (i < 15 ? i + 1 : 0) * 1024)); }
}

struct RgGeom { size_t rowbase; int t0, len, lat; };
__device__ __forceinline__ RgGeom rg_geom(int ci, int dir, int b) {
    RgGeom r;
    if (ci < 4) { const int ck = dir ? 3 - ci : ci; r.rowbase = (size_t)NL + b * TC; r.t0 = ck * 64; r.len = TC; r.lat = 0; }
    else { const int ck = dir ? 31 - (ci - 4) : ci - 4; r.rowbase = (size_t)b * T; r.t0 = ck * 64; r.len = T; r.lat = 1; }
    return r;
}
constexpr int RG2_WB = 0, RG2_CAR = 18432, RG2_FLG = RG2_CAR + 73 * 256, RG2_WV = RG2_FLG + 320, RG2_RAWST = 160, RG2_RAWSZ = 36 * RG2_RAWST, RG2_XASZ = 32 * 144, RG2_WVSZ = RG2_RAWSZ + RG2_XASZ, RG2_END = RG2_WV + 8 * RG2_WVSZ;
static_assert(RG2_END <= RING_BYTES, "RG LDS");
typedef float f32x16_t __attribute__((ext_vector_type(16)));
struct Rg2Geom { size_t rowbase; int p0, len; };
__device__ __forceinline__ Rg2Geom rg2_geom(int k, int b) { Rg2Geom r; if (k < 8) { r.rowbase = (size_t)NL + b * TC; r.p0 = 32 * k; r.len = TC; } else { r.rowbase = (size_t)b * T; r.p0 = 32 * (k - 8); r.len = T; } return r; }
__device__ __forceinline__ void rg2_load(const bf16_t* h, int k, int dir, int b, int g, int lane, v4u (&R)[5]) {
    const Rg2Geom gm = rg2_geom(k < 72 ? k : 71, b);
#pragma unroll
    for (int j = 0; j < 5; ++j) { const int idx = lane + 64 * j, ri = idx >> 3, c8 = idx & 7, p = gm.p0 + ri - 2; const bool ok = p >= 0 && p < gm.len && ri < 36; const int tk = ok ? (dir ? gm.len - 1 - p : p) : 0;
        R[j] = *(const v4u*)(h + (gm.rowbase + tk) * HC + HC_RX + g * 64 + c8 * 8); }
}
__device__ __forceinline__ void rg2_stage(LAS unsigned char* raw, int k, int b, int lane, const v4u (&R)[5]) {
    const Rg2Geom gm = rg2_geom(k < 72 ? k : 71, b); const v4u z = (v4u){0u, 0u, 0u, 0u};
#pragma unroll
    for (int j = 0; j < 5; ++j) { const int idx = lane + 64 * j, ri = idx >> 3, c8 = idx & 7, p = gm.p0 + ri - 2; const bool ok = p >= 0 && p < gm.len;
        if (j < 4 || ri < 36) *(LAS v4u*)(raw + ri * RG2_RAWST + c8 * 16) = ok ? R[j] : z; }
}
template <bool LAT>
__device__ __forceinline__ void rg2_tile(const bf16_t* h, bf16_t* y, int k, int dir, int b, int g, int lane, LAS unsigned char* L, LAS unsigned char* wv,
                                         const float (&w4)[2][4], const float (&cb)[2], const float (&ba)[2], const float (&bx)[2], const float (&sp)[2], v4u (&R)[5]) {
    LAS unsigned char* raw = wv; LAS unsigned* XA = (LAS unsigned*)(wv + RG2_RAWSZ); const LAS bf16_t* WB = (const LAS bf16_t*)(L + RG2_WB);
    volatile LAS float* CAR = (volatile LAS float*)(L + RG2_CAR); volatile LAS unsigned* FLG = (volatile LAS unsigned*)(L + RG2_FLG);
    const int cl = lane & 31, hh = lane >> 5;
    const LAS unsigned char* rawl = raw + (4 * hh + (dir ? 1 : 0)) * RG2_RAWST + cl * 4;
#pragma unroll
    for (int gi = 0; gi < 4; ++gi) { float rv[2][7];
#pragma unroll
        for (int m = 0; m < 7; ++m) { const unsigned wd = *(const LAS unsigned*)(rawl + (8 * gi + m) * RG2_RAWST); rv[0][m] = __uint_as_float(wd << 16); rv[1][m] = __uint_as_float(wd & 0xffff0000u); }
#pragma unroll
        for (int t = 0; t < 4; ++t) { float v0 = cb[0], v1 = cb[1];
#pragma unroll
            for (int m = 0; m < 4; ++m) { v0 += w4[0][m] * rv[0][t + m]; v1 += w4[1][m] * rv[1][t + m]; }
            XA[(8 * gi + 4 * hh + t) * 36 + cl] = pk2(v0, v1); } }
    f32x16_t acc[4];
#pragma unroll
    for (int i = 0; i < 4; ++i)
#pragma unroll
        for (int r = 0; r < 16; ++r) acc[i][r] = 0.f;
#pragma unroll
    for (int ks = 0; ks < 4; ++ks) { const pg8::bf16x8 af = *(const LAS pg8::bf16x8*)((const LAS bf16_t*)XA + cl * 72 + 16 * ks + 8 * hh);
#pragma unroll
        for (int n4 = 0; n4 < 4; ++n4) { const pg8::bf16x8 bfr = *(const LAS pg8::bf16x8*)(WB + (64 * (n4 >> 1) + 2 * cl + (n4 & 1)) * 72 + 16 * ks + 8 * hh);
            acc[n4] = __builtin_amdgcn_mfma_f32_32x32x16_bf16(af, bfr, acc[n4], 0, 0, 0); } }
    float Pl[2][4], Ph[2][4], Hl[2][4], Hh[2][4], PT[2] = {1.f, 1.f}, HT[2] = {0.f, 0.f};
#pragma unroll
    for (int gi = 0; gi < 4; ++gi) { unsigned xw[4];
#pragma unroll
        for (int t = 0; t < 4; ++t) xw[t] = XA[(8 * gi + 4 * hh + t) * 36 + cl];
#pragma unroll
        for (int nb = 0; nb < 2; ++nb) { float P = 1.f, H = 0.f;
#pragma unroll
            for (int tp = 0; tp < 4; tp += 2) { const int r = 4 * gi + tp;
                const f32x2_t xc2 = nb ? (f32x2_t){__uint_as_float(xw[tp] & 0xffff0000u), __uint_as_float(xw[tp + 1] & 0xffff0000u)} : (f32x2_t){__uint_as_float(xw[tp] << 16), __uint_as_float(xw[tp + 1] << 16)};
                const f32x2_t zr = (f32x2_t){acc[nb][r], acc[nb][r + 1]} + ba[nb], zi = (f32x2_t){acc[2 + nb][r], acc[2 + nb][r + 1]} + bx[nb];
                const f32x2_t er = (f32x2_t){__builtin_amdgcn_exp2f(zr.x), __builtin_amdgcn_exp2f(zr.y)} + 1.0f, ei = (f32x2_t){__builtin_amdgcn_exp2f(zi.x), __builtin_amdgcn_exp2f(zi.y)} + 1.0f;
                const f32x2_t gr = (f32x2_t){__builtin_amdgcn_rcpf(er.x), __builtin_amdgcn_rcpf(er.y)}, gq = (f32x2_t){__builtin_amdgcn_rcpf(ei.x), __builtin_amdgcn_rcpf(ei.y)};
                const f32x2_t la = gr * sp[nb]; const f32x2_t av = (f32x2_t){__builtin_amdgcn_exp2f(la.x), __builtin_amdgcn_exp2f(la.y)}; const f32x2_t om = 1.0f - av * av;
                const f32x2_t bb = (f32x2_t){__builtin_amdgcn_sqrtf(om.x), __builtin_amdgcn_sqrtf(om.y)} * gq * xc2;
                acc[nb][r] = av.x; acc[nb][r + 1] = av.y; acc[2 + nb][r] = bb.x; acc[2 + nb][r + 1] = bb.y;
                H = av.x * H + bb.x; P *= av.x; H = av.y * H + bb.y; P *= av.y; }
            const float Pp = __shfl_xor(P, 32), Hp = __shfl_xor(H, 32);
            Pl[nb][gi] = hh ? Pp : P; Ph[nb][gi] = hh ? P : Pp; Hl[nb][gi] = hh ? Hp : H; Hh[nb][gi] = hh ? H : Hp;
            HT[nb] = Pl[nb][gi] * HT[nb] + Hl[nb][gi]; PT[nb] *= Pl[nb][gi]; HT[nb] = Ph[nb][gi] * HT[nb] + Hh[nb][gi]; PT[nb] *= Ph[nb][gi]; }
        __builtin_amdgcn_sched_barrier(0); }
    while (__builtin_amdgcn_readfirstlane((int)FLG[k]) == 0) __builtin_amdgcn_s_sleep(1);
    asm volatile("" ::: "memory");
    float c[2]; c[0] = CAR[k * 64 + 2 * cl]; c[1] = CAR[k * 64 + 2 * cl + 1];
    if (hh == 0) { CAR[(k + 1) * 64 + 2 * cl] = PT[0] * c[0] + HT[0]; CAR[(k + 1) * 64 + 2 * cl + 1] = PT[1] * c[1] + HT[1]; }
    asm volatile("s_waitcnt lgkmcnt(0)" ::: "memory");
    if (lane == 0) FLG[k + 1] = 1u;
    const Rg2Geom gm = rg2_geom(k, b);
#pragma unroll
    for (int gi = 0; gi < 4; ++gi) { float hq[2];
#pragma unroll
        for (int nb = 0; nb < 2; ++nb) { const float clo = c[nb]; const float chi = Pl[nb][gi] * clo + Hl[nb][gi]; c[nb] = Ph[nb][gi] * chi + Hh[nb][gi]; hq[nb] = hh ? chi : clo; }
#pragma unroll
        for (int t = 0; t < 4; ++t) { const int r = 4 * gi + t; hq[0] = acc[0][r] * hq[0] + acc[2][r]; hq[1] = acc[1][r] * hq[1] + acc[3][r];
            if (LAT) { const int p = gm.p0 + 8 * gi + 4 * hh + t, tok = dir ? gm.len - 1 - p : p;
                *(unsigned*)(y + ((size_t)dir * NL + gm.rowbase + tok) * 512 + g * 64 + 2 * cl) = pk2(hq[0], hq[1]); } } }
    rg2_stage(raw, k + 8, b, lane, R);
    rg2_load(h, k + 16, dir, b, g, lane, R);
}
__device__ __forceinline__ void p3_rg(Frame& F, const bf16_t* h, const float* conv_w, const float* conv_b, const float* w_a, const float* b_a, const float* w_x, const float* b_x, const float* lam, bf16_t* y) {
    LAS unsigned char* L = F.lds; LAS bf16_t* WB = (LAS bf16_t*)(L + RG2_WB); LAS unsigned char* wv = L + RG2_WV + F.wave * RG2_WVSZ;
    for (int it0 = F.vcu; it0 < 256; it0 += F.G) { const int item = ((it0 >> 3) & 1) * 128 + (2 * (it0 >> 5) + ((it0 >> 4) & 1)) * 8 + (it0 & 7);
        const int g = item & 7, b = (item >> 3) & 15, dir = item >> 7, tid = F.tid, lane = F.lane, w = F.wave;
        __syncthreads();
        for (int i = tid; i < 8192; i += NTHREADS) { const int n = i & 127, k = i >> 7;
            const float v = n < 64 ? w_a[((size_t)(dir * 8 + g) * 64 + k) * 64 + n] : w_x[((size_t)(dir * 8 + g) * 64 + k) * 64 + n - 64]; WB[n * 72 + k] = f2bf_hw(v * -1.4426950408889634f); }
        if (tid < 73) ((LAS unsigned*)(L + RG2_FLG))[tid] = tid == 0 ? 1u : 0u;
        if (tid < 64) ((LAS float*)(L + RG2_CAR))[tid] = 0.f;
        float w4[2][4], cb[2], ba[2], bx[2], sp[2];
#pragma unroll
        for (int nb = 0; nb < 2; ++nb) { const int ch = g * 64 + 2 * (lane & 31) + nb; const float c0 = conv_w[ch], c1 = conv_w[512 + ch], c2 = conv_w[1024 + ch], c3 = conv_w[1536 + ch];
            w4[nb][0] = dir ? c3 : c0; w4[nb][1] = dir ? c2 : c1; w4[nb][2] = dir ? c1 : c2; w4[nb][3] = dir ? c0 : c3; cb[nb] = conv_b[ch];
            ba[nb] = b_a[dir * 512 + ch] * -1.4426950408889634f; bx[nb] = b_x[dir * 512 + ch] * -1.4426950408889634f; sp[nb] = -8.0f * 1.4426950408889634f * softplusf_(-lam[dir * 512 + ch]); }
        v4u R[5];
        rg2_load(h, w, dir, b, g, lane, R);
        rg2_stage(wv, w, b, lane, R);
        rg2_load(h, w + 8, dir, b, g, lane, R);
        __syncthreads();
        rg2_tile<false>(h, y, w, dir, b, g, lane, L, wv, w4, cb, ba, bx, sp, R);
        for (int it = 1; it < 9; ++it) rg2_tile<true>(h, y, w + 8 * it, dir, b, g, lane, L, wv, w4, cb, ba, bx, sp, R);
    }
}

constexpr int GL_OPS = 0, GL_OPSZ = 36864  , GL_ST = 2 * GL_OPSZ  , GL_LA = GL_ST + 2 * 9216  , GL_RAW = GL_LA + 4 * 16 * 68 * 4,
              GL_RAWSZ = 6656  , GL_SUBT = GL_RAW + 4 * GL_RAWSZ  , GL_GAM = GL_SUBT + 2048  , GL_END = GL_GAM + 512;
static_assert(GL_END <= RING_BYTES, "GLA LDS");
struct GlRegs { v4u q[2], k[2], v[2], lr; };
__device__ __forceinline__ void gl_load(const bf16_t* h, int ci, int dir, int b, int hd, int dvh, int w, int lane, GlRegs& R) {
    const RgGeom gm = rg_geom(ci < 36 ? ci : 35, dir, b);
#pragma unroll
    for (int j = 0; j < 2; ++j) { const int idx = lane + 64 * j, p = 16 * w + (idx >> 3), c8 = idx & 7, tok = dir ? 63 - p : p; const bf16_t* hr = h + (gm.rowbase + gm.t0 + tok) * HC;
        R.q[j] = *(const v4u*)(hr + HC_Q + hd * 64 + c8 * 8); R.k[j] = *(const v4u*)(hr + HC_K + hd * 64 + c8 * 8); R.v[j] = *(const v4u*)(hr + HC_V + hd * 128 + dvh * 64 + c8 * 8); }
    { const int l2 = lane & 31, p = 16 * w + (l2 >> 1), hf = l2 & 1, tok = dir ? 63 - p : p; R.lr = *(const v4u*)(h + (gm.rowbase + gm.t0 + tok) * HC + HC_LR + dir * 16 + hf * 8); }
}
__device__ __forceinline__ void gl_stage(LAS unsigned char* rawp, int lane, const GlRegs& R) {
#pragma unroll
    for (int j = 0; j < 2; ++j) { *(LAS v4u*)(rawp + (lane + 64 * j) * 16) = R.q[j]; *(LAS v4u*)(rawp + 2048 + (lane + 64 * j) * 16) = R.k[j]; *(LAS v4u*)(rawp + 4096 + (lane + 64 * j) * 16) = R.v[j]; }
    if (lane < 32) *(LAS v4u*)(rawp + 6144 + lane * 16) = R.lr;
}
__device__ __forceinline__ pg8::bf16x8 pack_bf8(const pg8::f32x4& lo, const pg8::f32x4& hi) {
    v4u w; w.x = pk2(lo[0], lo[1]); w.y = pk2(lo[2], lo[3]); w.z = pk2(hi[0], hi[1]); w.w = pk2(hi[2], hi[3]); return __builtin_bit_cast(pg8::bf16x8, w);
}
typedef short s16x4_t __attribute__((ext_vector_type(4)));
__device__ __forceinline__ pg8::bf16x8 cat4(const s16x4_t a, const s16x4_t b) { return __builtin_shufflevector(a, b, 0, 1, 2, 3, 4, 5, 6, 7); }

__device__ __forceinline__ void gl_e_gates(Frame& F, int w, const pg8::bf16x8 (&wgf)[4], float bg, float (&lc)[16], LAS float* SUBT) {
    LAS unsigned char* L = F.lds; LAS float* ZL = (LAS float*)(L + GL_LA) + w * (16 * 68); const LAS bf16_t* LR = (const LAS bf16_t*)(L + GL_RAW + w * GL_RAWSZ + 6144);
    const int lane = F.lane, fr = lane & 15, fq = lane >> 4;
    pg8::bf16x8 af = *(const LAS pg8::bf16x8*)(LR + fr * 16 + 8 * (fq & 1));
    if (fq >= 2) af = (pg8::bf16x8){0, 0, 0, 0, 0, 0, 0, 0};
#pragma unroll
    for (int nt = 0; nt < 4; ++nt) { pg8::f32x4 z = (pg8::f32x4){0.f, 0.f, 0.f, 0.f}; z = __builtin_amdgcn_mfma_f32_16x16x32_bf16(af, wgf[nt], z, 0, 0, 0);
#pragma unroll
        for (int r = 0; r < 4; ++r) ZL[(4 * fq + r) * 68 + 16 * nt + fr] = z[r]; }
    float run = 0.f;
#pragma unroll
    for (int i = 0; i < 16; ++i) { const float zn = ZL[i * 68 + lane] + bg;
        run -= __builtin_amdgcn_logf(1.0f + __builtin_amdgcn_exp2f(zn)) * (1.0f / 16.0f); lc[i] = run; }
    SUBT[w * 64 + lane] = run;
}
__device__ __forceinline__ void gl_e_ops(Frame& F, int w, LAS unsigned char* ob, LAS float* GAM, const float (&lc)[16], const LAS float* SUBT) {
    LAS unsigned char* L = F.lds; LAS bf16_t* QD = (LAS bf16_t*)ob; LAS bf16_t* KI = (LAS bf16_t*)(ob + 9216); LAS bf16_t* KDT = (LAS bf16_t*)(ob + 18432); LAS bf16_t* VT = (LAS bf16_t*)(ob + 27648);
    const LAS unsigned char* rawp = L + GL_RAW + w * GL_RAWSZ;
    const LAS bf16_t* QR = (const LAS bf16_t*)rawp; const LAS bf16_t* KR = (const LAS bf16_t*)(rawp + 2048); const LAS bf16_t* VR = (const LAS bf16_t*)(rawp + 4096);
    const int dk = F.lane;
    float off = 0.f, tot = 0.f;
#pragma unroll
    for (int s2 = 0; s2 < 4; ++s2) { const float v = SUBT[s2 * 64 + dk]; tot += v; if (s2 < w) off += v; }
    if (w == 0) GAM[dk] = __builtin_amdgcn_exp2f(tot);
    unsigned kd[16], vt[16];
#pragma unroll
    for (int i = 0; i < 16; ++i) { const int p = 16 * w + i; const float bc = lc[i] + off; const float qv = bf2f(QR[i * 64 + dk]), kv = bf2f(KR[i * 64 + dk]);
        const float eb = __builtin_amdgcn_exp2f(bc); QD[p * 72 + dk] = f2bf_hw(qv * eb); kd[i] = f2bf_hw(kv * __builtin_amdgcn_rcpf(eb)); KI[p * 72 + dk] = (bf16_t)kd[i]; vt[i] = VR[i * 64 + dk]; }
#pragma unroll
    for (int hf = 0; hf < 2; ++hf) { v4u wk, wv; wk.x = kd[8 * hf + 0] | (kd[8 * hf + 1] << 16); wk.y = kd[8 * hf + 2] | (kd[8 * hf + 3] << 16); wk.z = kd[8 * hf + 4] | (kd[8 * hf + 5] << 16); wk.w = kd[8 * hf + 6] | (kd[8 * hf + 7] << 16);
        wv.x = vt[8 * hf + 0] | (vt[8 * hf + 1] << 16); wv.y = vt[8 * hf + 2] | (vt[8 * hf + 3] << 16); wv.z = vt[8 * hf + 4] | (vt[8 * hf + 5] << 16); wv.w = vt[8 * hf + 6] | (vt[8 * hf + 7] << 16);
        *(LAS v4u*)(KDT + dk * 72 + 16 * w + 8 * hf) = wk; *(LAS v4u*)(VT + dk * 72 + 16 * w + 8 * hf) = wv; }
}
__device__ __forceinline__ void gl_m_vt(Frame& F, int m, LAS unsigned char* ob) {
    LAS unsigned char* L = F.lds; LAS bf16_t* VT = (LAS bf16_t*)(ob + 27648); const LAS bf16_t* VR = (const LAS bf16_t*)(L + GL_RAW + m * GL_RAWSZ + 4096); const int dv = F.lane;
    unsigned pr[8];
#pragma unroll
    for (int i = 0; i < 8; ++i) pr[i] = (unsigned)VR[(2 * i) * 64 + dv] | ((unsigned)VR[(2 * i + 1) * 64 + dv] << 16);
    v4u w0, w1; w0.x = pr[0]; w0.y = pr[1]; w0.z = pr[2]; w0.w = pr[3]; w1.x = pr[4]; w1.y = pr[5]; w1.z = pr[6]; w1.w = pr[7];
    *(LAS v4u*)(VT + dv * 72 + 16 * m) = w0; *(LAS v4u*)(VT + dv * 72 + 16 * m + 8) = w1;
}
__device__ __forceinline__ void gl_m_out(Frame& F, int ci, int dir, int b, int hd, int dvh, int ti, const LAS unsigned char* ob, const LAS bf16_t* STr, bf16_t* o) {
    const LAS bf16_t* QD = (const LAS bf16_t*)ob; const LAS bf16_t* KI = (const LAS bf16_t*)(ob + 9216); const LAS bf16_t* VT = (const LAS bf16_t*)(ob + 27648);
    const RgGeom gm = rg_geom(ci, dir, b);
    const int lane = F.lane, fr = lane & 15, fq = lane >> 4;
    pg8::bf16x8 qf[2], kf[4][2];
#pragma unroll
    for (int ks = 0; ks < 2; ++ks) qf[ks] = *(const LAS pg8::bf16x8*)(QD + (16 * ti + fr) * 72 + 32 * ks + 8 * fq);
#pragma unroll
    for (int mj = 0; mj < 4; ++mj)
#pragma unroll
        for (int ks = 0; ks < 2; ++ks) kf[mj][ks] = *(const LAS pg8::bf16x8*)(KI + (16 * mj + fr) * 72 + 32 * ks + 8 * fq);
    pg8::bf16x8 vf[2][4];
#pragma unroll
    for (int kk = 0; kk < 2; ++kk)
#pragma unroll
        for (int j = 0; j < 4; ++j) { const LAS bf16_t* vp = VT + (16 * j + fr) * 72 + 32 * kk + 4 * fq; vf[kk][j] = cat4(*(const LAS s16x4_t*)vp, *(const LAS s16x4_t*)(vp + 16)); }
    pg8::f32x4 ct[4];
    const int thr = 16 * ti + fr - 4 * fq;
#pragma unroll
    for (int mj = 0; mj < 4; ++mj) { ct[mj] = (pg8::f32x4){0.f, 0.f, 0.f, 0.f};
#pragma unroll
        for (int ks = 0; ks < 2; ++ks) ct[mj] = __builtin_amdgcn_mfma_f32_16x16x32_bf16(kf[mj][ks], qf[ks], ct[mj], 0, 0, 0);
#pragma unroll
        for (int r = 0; r < 4; ++r) ct[mj][r] = (16 * mj + r > thr) ? 0.f : ct[mj][r]; }
    pg8::f32x4 oacc[4];
#pragma unroll
    for (int j = 0; j < 4; ++j) oacc[j] = (pg8::f32x4){0.f, 0.f, 0.f, 0.f};
#pragma unroll
    for (int kk = 0; kk < 2; ++kk) { const pg8::bf16x8 sf = pack_bf8(ct[2 * kk], ct[2 * kk + 1]);
#pragma unroll
        for (int j = 0; j < 4; ++j) oacc[j] = __builtin_amdgcn_mfma_f32_16x16x32_bf16(vf[kk][j], sf, oacc[j], 0, 0, 0); }
#pragma unroll
    for (int j = 0; j < 4; ++j) { const int dv = 16 * j + fr;
#pragma unroll
        for (int ks = 0; ks < 2; ++ks) { const pg8::bf16x8 sf = *(const LAS pg8::bf16x8*)(STr + dv * 72 + 32 * ks + 8 * fq); oacc[j] = __builtin_amdgcn_mfma_f32_16x16x32_bf16(sf, qf[ks], oacc[j], 0, 0, 0); } }
    { const int p = 16 * ti + fr, tok = dir ? 63 - p : p; bf16_t* orow = o + ((size_t)dir * NL + gm.rowbase + gm.t0 + tok) * 512 + hd * 128 + dvh * 64;
#pragma unroll
      for (int j = 0; j < 4; ++j) { v2u wv; wv.x = pk2(oacc[j][0] * 0.125f, oacc[j][1] * 0.125f); wv.y = pk2(oacc[j][2] * 0.125f, oacc[j][3] * 0.125f); *(v2u*)(orow + 16 * j + 4 * fq) = wv; } }
}
__device__ __forceinline__ void gl_m_state(Frame& F, int mt, const LAS unsigned char* ob, const LAS float* GAM, LAS bf16_t* STw, pg8::f32x4 (&sacc)[4]) {
    const LAS bf16_t* KDT = (const LAS bf16_t*)(ob + 18432); const LAS bf16_t* VT = (const LAS bf16_t*)(ob + 27648);
    const int lane = F.lane, fr = lane & 15, fq = lane >> 4;
#pragma unroll
    for (int ks = 0; ks < 2; ++ks) { const pg8::bf16x8 kf = *(const LAS pg8::bf16x8*)(KDT + (16 * mt + fr) * 72 + 32 * ks + 8 * fq);
#pragma unroll
        for (int j = 0; j < 4; ++j) { const pg8::bf16x8 vf = *(const LAS pg8::bf16x8*)(VT + (16 * j + fr) * 72 + 32 * ks + 8 * fq); sacc[j] = __builtin_amdgcn_mfma_f32_16x16x32_bf16(kf, vf, sacc[j], 0, 0, 0); } }
    float gmv[4];
#pragma unroll
    for (int r = 0; r < 4; ++r) gmv[r] = GAM[16 * mt + 4 * fq + r];
#pragma unroll
    for (int j = 0; j < 4; ++j) {
#pragma unroll
        for (int r = 0; r < 4; ++r) sacc[j][r] *= gmv[r];
        v2u wv; wv.x = pk2(sacc[j][0], sacc[j][1]); wv.y = pk2(sacc[j][2], sacc[j][3]); *(LAS v2u*)(STw + (16 * j + fr) * 72 + 16 * mt + 4 * fq) = wv; }
}
__device__ __forceinline__ void gl_e_step(Frame& F, int s, int wq, int dir, int b, int hd, int dvh, const bf16_t* h, const pg8::bf16x8 (&wgf)[4], float bg, float (&lc)[16], GlRegs& NR) {
    LAS unsigned char* L = F.lds;
    gl_e_ops(F, wq, L + GL_OPS + (s & 1) * GL_OPSZ, (LAS float*)(L + GL_GAM + (s & 1) * 256), lc, (const LAS float*)(L + GL_SUBT + (s & 1) * 1024));
    gl_stage(L + GL_RAW + wq * GL_RAWSZ, F.lane, NR); gl_load(h, s + 3, dir, b, hd, dvh, wq, F.lane, NR);
    gl_e_gates(F, wq, wgf, bg, lc, (LAS float*)(L + GL_SUBT + ((s + 1) & 1) * 1024));
}
__device__ __forceinline__ void gl_m_step(Frame& F, int s, int wq, int dir, int b, int hd, int dvh, bf16_t* o, pg8::f32x4 (&sacc)[4]) {
    LAS unsigned char* L = F.lds;
    if (s >= 5) gl_m_out(F, s - 1, dir, b, hd, dvh, wq, L + GL_OPS + ((s - 1) & 1) * GL_OPSZ, (const LAS bf16_t*)(L + GL_ST + ((s - 1) & 1) * 9216), o);
    if (s >= 1) gl_m_state(F, wq, L + GL_OPS + ((s - 1) & 1) * GL_OPSZ, (const LAS float*)(L + GL_GAM + ((s - 1) & 1) * 256), (LAS bf16_t*)(L + GL_ST + (s & 1) * 9216), sacc);
}
__device__ __forceinline__ void p3_gla(Frame& F, const bf16_t* h, const float* w_g, const float* b_g, bf16_t* o) {
    LAS unsigned char* L = F.lds;
    for (int it0 = F.vcu; it0 < 256; it0 += F.G) { const int item = ((it0 >> 3) & 1) * 128 + (2 * (it0 >> 5) + ((it0 >> 4) & 1)) * 8 + (it0 & 7);
        const int dvh = item & 1, hd = (item >> 1) & 3, b = (item >> 3) & 15, dir = item >> 7, tid = F.tid, lane = F.lane;
        const bool isE = F.wave < 4; const int wq = F.wave & 3;
        __syncthreads();
        for (int i = tid; i < 9216 / 4; i += NTHREADS) ((LAS unsigned*)(L + GL_ST))[i] = 0u;
        pg8::bf16x8 wgf[4];
        { const int fr = lane & 15, fq = lane >> 4;
#pragma unroll
          for (int j = 0; j < 4; ++j) { float t[8];
#pragma unroll
              for (int e = 0; e < 8; ++e) t[e] = fq < 2 ? w_g[(size_t)(dir * 16 + 8 * fq + e) * 256 + hd * 64 + 16 * j + fr] * -1.4426950408889634f : 0.f;
              v4u wv; wv.x = pk2(t[0], t[1]); wv.y = pk2(t[2], t[3]); wv.z = pk2(t[4], t[5]); wv.w = pk2(t[6], t[7]); wgf[j] = __builtin_bit_cast(pg8::bf16x8, wv); } }
        const float bg = b_g[dir * 256 + hd * 64 + lane] * -1.4426950408889634f;
        pg8::f32x4 sacc[4];
#pragma unroll
        for (int j = 0; j < 4; ++j) sacc[j] = (pg8::f32x4){0.f, 0.f, 0.f, 0.f};
        float lc[16];
#pragma unroll
        for (int i = 0; i < 16; ++i) lc[i] = 0.f;
        GlRegs RA, RB;
        gl_load(h, 0, dir, b, hd, dvh, wq, lane, RA); if (isE) gl_stage(L + GL_RAW + wq * GL_RAWSZ, lane, RA);
        gl_load(h, 1, dir, b, hd, dvh, wq, lane, RA); gl_load(h, 2, dir, b, hd, dvh, wq, lane, RB);
        if (isE) gl_e_gates(F, wq, wgf, bg, lc, (LAS float*)(L + GL_SUBT));
        __syncthreads();
        if (isE) {
            for (int s = 0; s < 36; s += 2) {
                gl_e_step(F, s, wq, dir, b, hd, dvh, h, wgf, bg, lc, RA); WG_BAR();
                gl_e_step(F, s + 1, wq, dir, b, hd, dvh, h, wgf, bg, lc, RB); WG_BAR();
            }
            WG_BAR();
        } else {
            for (int s = 0; s < 37; ++s) { gl_m_step(F, s, wq, dir, b, hd, dvh, o, sacc); WG_BAR(); }
        }
    }
}

__global__ void __launch_bounds__(NTHREADS, 2) mega(Args args) {
    extern __shared__ __attribute__((aligned(16))) unsigned char lds[];
    Frame F;
    F.lds = (LAS unsigned char*)lds; F.MISC = (volatile LAS unsigned*)(F.lds + MISC_OFF);
    F.tid = threadIdx.x; F.lane = F.tid & 63; F.wave = __builtin_amdgcn_readfirstlane(F.tid >> 6);
    F.G = gridDim.x; { const int bx = blockIdx.x; F.vcu = (F.G % 8 == 0) ? (bx % 8) * (F.G / 8) + bx / 8 : bx; }
    unsigned char* ws = args.ws;
    unsigned* ctl = (unsigned*)(ws + OFF_CTL);
    for (int u = F.tid; u < (LDS_BYTES - LDSCTL_OFF) / 4; u += NTHREADS) ((LAS unsigned*)(F.lds + LDSCTL_OFF))[u] = 0u;
    __syncthreads();
    XcdBarrier bar = xcd_barrier_post(ctl + CW_BAR, F.MISC + 8);
    const int lo = args.ph_lo, hi = args.ph_hi;
#define IN(k) (lo <= (k) && (k) < hi)
#define BOTH(k) (IN(k) && IN((k) + 1))
    float* mod = (float*)(ws + OFF_MOD); float* pe = (float*)(ws + OFF_PE);
    if (IN(0)) { p0_mod_pe(F, args.in[1], args.in[3], args.in[4], args.in[5], mod, pe); if (BOTH(0)) xcd_barrier(bar); }
    if (IN(1)) { { p1_prologue(F, args); __syncthreads(); } if (BOTH(1)) xcd_barrier(bar); }
    if (IN(2)) {
        pg8::Gemm g{(const bf16_t*)(ws + OFF_XA), (const bf16_t*)(ws + OFF_WINT), NTOK, HC, D};
        Sched1 S{F.G, (int)blockIdx.x};
        pg8::EpiBf16<0> E{(bf16_t*)(ws + OFF_H), HC, nullptr, 0, 0, 1.f};
        pg8::gemm_phase<pg8::EpiBf16<0>, Sched1, true, true>(F.lds + RING_OFF, g, S, E);
        if (BOTH(2)) xcd_barrier(bar);
    }
    bf16_t* hbuf = (bf16_t*)(ws + OFF_H); bf16_t* ybuf = (bf16_t*)(ws + OFF_Y); bf16_t* obuf = (bf16_t*)(ws + OFF_O); bf16_t* a2 = (bf16_t*)(ws + OFF_A2);
    bf16_t* ubuf = (bf16_t*)(ws + OFF_U); float* sbuf = (float*)(ws + OFF_S);
    if (IN(3)) { {
        p3_rg(F, hbuf, args.in[8], args.in[9], args.in[10], args.in[11], args.in[12], args.in[13], args.in[14], ybuf);
        __syncthreads();
        p3_gla(F, hbuf, args.in[15], args.in[16], obuf);
        __syncthreads(); }
        if (BOTH(3)) xcd_barrier(bar);
    }
    if (IN(4)) { p4_merge(F, hbuf, ybuf, obuf, args.in[17], a2); if (BOTH(4)) xcd_barrier(bar); }
    if (IN(5)) {
        pg8::Gemm g{a2, (const bf16_t*)(ws + OFF_WOUTT), NL, D, D};
        pg8::StaticOrder S; S.init(NL, D, F.G, (int)blockIdx.x);
        EpiX1 E{args.in[0], pe, mod, (bf16_t*)(ws + OFF_Y)};
        pg8::gemm_phase<EpiX1, pg8::StaticOrder, true, true>(F.lds + RING_OFF, g, S, E);
        if (BOTH(5)) xcd_barrier(bar);
    }
    if (IN(6)) { p6_norm2(F, (const bf16_t*)(ws + OFF_Y), args.in[19], mod, ubuf); if (BOTH(6)) xcd_barrier(bar); }
    if (IN(7)) {
        pg8::Gemm g{ubuf, (const bf16_t*)(ws + OFF_WST), NL, 2048, D};
        StaticOrderW4 S; S.init(NL, 2048, F.G, (int)blockIdx.x);
        EpiS E{(unsigned short*)sbuf};
        pg8::gemm_phase<EpiS, StaticOrderW4, true, true>(F.lds + RING_OFF, g, S, E);
        if (BOTH(7)) xcd_barrier(bar);
    }
    if (IN(8)) {
        p8a_route(F, sbuf, (const float*)(ws + OFF_TSC));
        p8b_peer(F, ubuf, (const unsigned char*)(ws + OFF_TABU), (const unsigned char*)(ws + OFF_TABV), mod, args.in[24], args.out, (unsigned char*)sbuf, (const bf16_t*)(ws + OFF_Y));
    }
#undef IN
#undef BOTH
}
}
extern "C" void kernel_launch(void* const* d_in, const int* in_sizes, int n_in, void* d_out, int out_size, void* d_ws, size_t ws_size, hipStream_t stream) {
    static int grid = 0;
    if (grid == 0) {
        if (ws_size < OFF_END || n_in != 25) { fprintf(stderr, "kernel_launch: workspace %zu < %zu or n_in %d != 25\n", ws_size, (size_t)OFF_END, n_in); grid = -1; return; }
        int dev = 0, cus = 0, per_cu = 0;
        if (hipGetDevice(&dev) != hipSuccess || hipDeviceGetAttribute(&cus, hipDeviceAttributeMultiprocessorCount, dev) != hipSuccess) { grid = -1; return; }
        if (hipFuncSetAttribute((const void*)mk::mega, hipFuncAttributeMaxDynamicSharedMemorySize, mk::LDS_BYTES) != hipSuccess) { fprintf(stderr, "kernel_launch: hipFuncSetAttribute failed\n"); grid = -1; return; }
        if (hipOccupancyMaxActiveBlocksPerMultiprocessor(&per_cu, (const void*)mk::mega, mk::NTHREADS, mk::LDS_BYTES) != hipSuccess || per_cu < 1) { fprintf(stderr, "kernel_launch: occupancy query says %d\n", per_cu); }
        (void)hipGetLastError();
        if (cus < 256) { fprintf(stderr, "kernel_launch: built for a 256-CU MI355X (one workgroup per CU, 16 tokens per wave in the PEER phases); this device reports %d CUs; nothing launched\n", cus); grid = -1; return; }
        grid = 256;
    }
    if (grid < 0) return;
    (void)hipMemsetAsync((char*)d_ws + OFF_CTL, 0, CTL_ZERO_BYTES, stream);
    mk::Args a{};
    for (int i = 0; i < 25; ++i) a.in[i] = (const float*)d_in[i];
    a.out = (float*)d_out; a.ws = (unsigned char*)d_ws; a.ph_lo = 0; a.ph_hi = 9;
    hipLaunchKernelGGL(mk::mega, dim3(grid), dim3(mk::NTHREADS), mk::LDS_BYTES, stream, a);
}
```
